# Optimizing an MI355X kernel written in HIP

```python
import jax
import jax.numpy as jnp
from jax import lax
import numpy as np

D_MODEL = 2048
BATCH = 4
SEQ = 2048
DEPTH = 1

MIX_WIDTH = D_MODEL
M_HEADS = 4
M_DV = MIX_WIDTH // 2 // M_HEADS
M_DQK = M_DV // 2
M_CHUNK = 64
CONV_WIDTH = 4
A_HEADS = 16
A_DH = MIX_WIDTH // 2 // A_HEADS
DILATED_GROUPS = ((128, 1), (512, 4), (2048, 16))
N_EXPERTS = 32
TOP_K = 4
D_EXPERT = D_MODEL
SWIGLU_ALPHA = 1.702
SWIGLU_LIMIT = 7.0
MOE_BLOCK = 128
DEEPNORM_ALPHA = (2 * DEPTH) ** 0.25
DEEPNORM_BETA = (8 * DEPTH) ** -0.25
EPS = 1e-5
M_QK_W = 2 * M_HEADS * M_DQK
M_V_W = M_HEADS * M_DV
A_W = A_HEADS * A_DH
PROJ_DIM = M_QK_W + 2 * M_V_W + 2 * M_HEADS + 3 * A_W

kernel_name = 'hymba_mlstm_dilated_alibi_moe_deepnorm'


def layer_norm(x, g, b):
    xf = x.astype(jnp.float32)
    mu = xf.mean(-1, keepdims=True)
    var = jnp.square(xf - mu).mean(-1, keepdims=True)
    return ((xf - mu) * lax.rsqrt(var + EPS) * g + b).astype(x.dtype)


def head_rms_norm(t, g):
    tf = t.astype(jnp.float32)
    return tf * lax.rsqrt(jnp.square(tf).mean(-1, keepdims=True) + EPS) * g


def causal_depthwise_conv(t, w, b):
    C = t.shape[-1]
    y = lax.conv_general_dilated(
        t, w[:, None, :].astype(t.dtype), window_strides=(1,),
        padding=((CONV_WIDTH - 1, 0),), dimension_numbers=('NWC', 'WIO', 'NWC'),
        feature_group_count=C)
    return y + b


def mlstm_chunkwise(q, k, v, ig, fg):
    B, S, H, DQK = q.shape
    DV = v.shape[-1]
    nc = S // M_CHUNK
    f32 = jnp.float32

    def to_chunks(t):
        t = t.astype(f32).reshape((B, nc, M_CHUNK) + t.shape[2:])
        return jnp.moveaxis(jnp.moveaxis(t, 3, 2), 1, 0)

    qc = to_chunks(q)
    kc = to_chunks(k) * (DQK ** -0.5)
    vc = to_chunks(v)
    igc = to_chunks(ig)
    lfc = to_chunks(jax.nn.log_sigmoid(fg.astype(f32)))
    causal = jnp.tril(jnp.ones((M_CHUNK, M_CHUNK), dtype=bool))

    def step(carry, xs):
        C, n, m = carry
        qx, kx, vx, i_, lf = xs
        b = jnp.cumsum(lf, axis=-1)
        dmat = jnp.where(causal, b[..., :, None] - b[..., None, :] + i_[..., None, :], -jnp.inf)
        inter = b + m[..., None]
        m_t = jnp.maximum(inter, dmat.max(-1))
        a = jnp.exp(dmat - m_t[..., None]) * jnp.einsum('bhtd,bhsd->bhts', qx, kx)
        e_inter = jnp.exp(inter - m_t)
        num = jnp.einsum('bhts,bhsv->bhtv', a, vx) + e_inter[..., None] * jnp.einsum('bhvd,bhtd->bhtv', C, qx)
        den = a.sum(-1) + e_inter * jnp.einsum('bhd,bhtd->bht', n, qx)
        h = num / jnp.maximum(jnp.abs(den), jnp.exp(-m_t))[..., None]
        g = b[..., -1:] - b + i_
        m_new = jnp.maximum(b[..., -1] + m, g.max(-1))
        w_s = jnp.exp(g - m_new[..., None])
        decay = jnp.exp(b[..., -1] + m - m_new)
        C = decay[..., None, None] * C + jnp.einsum('bhs,bhsv,bhsd->bhvd', w_s, vx, kx)
        n = decay[..., None] * n + jnp.einsum('bhs,bhsd->bhd', w_s, kx)
        return (C, n, m_new), h

    init = (jnp.zeros((B, H, DV, DQK), f32), jnp.zeros((B, H, DQK), f32), jnp.zeros((B, H), f32))
    _, hs = lax.scan(step, init, (qc, kc, vc, igc, lfc))
    hs = jnp.moveaxis(jnp.moveaxis(hs, 0, 1), 2, 3)
    return hs.reshape(B, S, H, DV)


def dilated_window_group(q, k, v, slopes, window, dilation):
    B, H, S, Dh = q.shape
    L = S // dilation
    nk = window // dilation
    nb = -(-L // nk)
    Lp = nb * nk

    def to_blocks(t):
        t = t.reshape(B, H, L, dilation, Dh).transpose(0, 1, 3, 2, 4)
        t = jnp.pad(t, ((0, 0), (0, 0), (0, 0), (0, Lp - L), (0, 0)))
        return t.reshape(B, H, dilation, nb, nk, Dh)

    qb, kb, vb = to_blocks(q), to_blocks(k), to_blocks(v)

    def with_prev(t):
        prev = jnp.pad(t[:, :, :, :-1], ((0, 0), (0, 0), (0, 0), (1, 0), (0, 0), (0, 0)))
        return jnp.concatenate([prev, t], axis=4)

    kk, vv = with_prev(kb), with_prev(vb)
    s = jnp.einsum('bhrnqd,bhrnkd->bhrnqk', qb, kk) * (Dh ** -0.5)
    qi = jnp.arange(nk)[:, None]
    ki = jnp.arange(2 * nk)[None, :]
    dist = nk + qi - ki
    first = (jnp.arange(nb) == 0)[:, None, None]
    valid = (dist >= 0) & (dist <= nk) & ~(first & (ki < nk))
    alibi = -slopes[:, None, None, None, None] * (dist * dilation).astype(jnp.float32)
    s = jnp.where(valid, s + alibi, -jnp.inf)
    m = s.max(-1)
    p = jnp.exp(s - m[..., None])
    l = p.sum(-1)
    num = jnp.einsum('bhrnqk,bhrnkd->bhrnqd', p, vv)

    def from_blocks(t):
        t = t.reshape((B, H, dilation, Lp) + t.shape[5:])[:, :, :, :L]
        t = jnp.swapaxes(t, 2, 3)
        return t.reshape((B, H, S) + t.shape[4:])

    return from_blocks(num), from_blocks(m), from_blocks(l)


def dilated_attention(q, k, v):
    H = q.shape[1]
    slopes = jnp.exp2(-8.0 * jnp.arange(1, H + 1, dtype=jnp.float32) / H)
    nums, ms, ls = [], [], []
    for window, dilation in DILATED_GROUPS:
        num, m, l = dilated_window_group(q, k, v, slopes, window, dilation)
        nums.append(num)
        ms.append(m)
        ls.append(l)
    m_all = jnp.stack(ms)
    w = jnp.exp(m_all - m_all.max(0))
    num = (w[..., None] * jnp.stack(nums)).sum(0)
    den = (w * jnp.stack(ls)).sum(0)
    return num / den[..., None]


def token_mixer(h, w_in, b_in, conv_w, conv_b, m_norm_g, a_norm_g, w_out):
    B, S, _ = h.shape
    proj = h @ w_in + b_in
    cuts = [int(i) for i in np.cumsum([M_QK_W, M_V_W, M_V_W, M_HEADS, M_HEADS, A_W, A_W])]
    qk_m, v_m, o_m, ig, fg, q_a, k_a, v_a = jnp.split(proj, cuts, axis=-1)

    qk_m = jax.nn.silu(causal_depthwise_conv(qk_m, conv_w, conv_b))
    q_m, k_m = jnp.split(qk_m, 2, axis=-1)
    h_m = mlstm_chunkwise(q_m.reshape(B, S, M_HEADS, M_DQK), k_m.reshape(B, S, M_HEADS, M_DQK),
                          v_m.reshape(B, S, M_HEADS, M_DV), ig, fg)
    h_m = head_rms_norm(h_m, m_norm_g.reshape(M_HEADS, M_DV)) * jax.nn.sigmoid(
        o_m.astype(jnp.float32)).reshape(B, S, M_HEADS, M_DV)
    y_m = h_m.reshape(B, S, M_V_W).astype(h.dtype)

    def heads(t):
        return t.reshape(B, S, A_HEADS, A_DH).transpose(0, 2, 1, 3).astype(jnp.float32)
    o_a = dilated_attention(heads(q_a), heads(k_a), heads(v_a))
    y_a = head_rms_norm(o_a.transpose(0, 2, 1, 3), a_norm_g.reshape(A_HEADS, A_DH))
    y_a = y_a.reshape(B, S, A_W).astype(h.dtype)

    return jnp.concatenate([y_m, y_a], axis=-1) @ w_out


def moe(h, router_w, router_b, w_gu, b_gu, w_dn, b_dn):
    B, S, D = h.shape
    T = B * S
    TK = T * TOP_K
    xt = h.reshape(T, D)
    logits = (xt @ router_w + router_b).astype(jnp.float32)
    top_val, top_idx = lax.top_k(logits, TOP_K)
    gates = jax.nn.softmax(top_val, axis=-1)
    e_flat = top_idx.reshape(TK).astype(jnp.int32)
    order = jnp.argsort(e_flat)
    e_sorted = e_flat[order]
    tok_sorted = (order // TOP_K).astype(jnp.int32)
    gate_sorted = gates.reshape(TK)[order].astype(h.dtype)
    counts = jnp.bincount(e_flat, length=N_EXPERTS)
    starts = jnp.cumsum(counts) - counts
    padded = ((counts + MOE_BLOCK - 1) // MOE_BLOCK) * MOE_BLOCK
    pad_end = jnp.cumsum(padded)
    pad_start = pad_end - padded
    dest = pad_start[e_sorted] + jnp.arange(TK, dtype=jnp.int32) - starts[e_sorted]
    R = TK + N_EXPERTS * MOE_BLOCK
    x_pad = jnp.zeros((R, D), h.dtype).at[dest].set(xt[tok_sorted])
    tok_pad = jnp.zeros((R,), jnp.int32).at[dest].set(tok_sorted)
    gate_pad = jnp.zeros((R,), h.dtype).at[dest].set(gate_sorted)
    n_blocks = R // MOE_BLOCK
    block_expert = jnp.minimum(
        jnp.searchsorted(pad_end, jnp.arange(n_blocks, dtype=jnp.int32) * MOE_BLOCK, side='right'),
        N_EXPERTS - 1)

    def expert_block(args):
        xb, e = args
        gu = xb @ w_gu[e] + b_gu[e]
        x_glu = jnp.minimum(gu[:, 0::2], SWIGLU_LIMIT)
        x_lin = jnp.clip(gu[:, 1::2], -SWIGLU_LIMIT, SWIGLU_LIMIT)
        act = x_glu * jax.nn.sigmoid(SWIGLU_ALPHA * x_glu) * (x_lin + 1)
        return act @ w_dn[e] + b_dn[e]

    y_pad = lax.map(expert_block, (x_pad.reshape(n_blocks, MOE_BLOCK, D), block_expert))
    y_pad = y_pad.reshape(R, D) * gate_pad[:, None]
    return jax.ops.segment_sum(y_pad, tok_pad, num_segments=T).reshape(B, S, D)


def setup_inputs(seed: int = 0) -> dict:
    key = jax.random.key(seed)
    ks = jax.random.split(key, 21)
    f32 = jnp.float32

    def nrm(k, shape, scale):
        return jax.random.normal(k, shape, f32) * scale

    x = nrm(ks[0], (BATCH, SEQ, D_MODEL), 1.0)
    c = nrm(ks[1], (BATCH, D_MODEL), 1.0)
    w_ada = nrm(ks[2], (DEPTH, D_MODEL, 6 * D_MODEL), 0.1 * D_MODEL ** -0.5)
    b_ada = nrm(ks[3], (DEPTH, 6 * D_MODEL), 0.02)
    col_scale = jnp.concatenate([
        jnp.ones((M_QK_W,), f32), jnp.full((M_V_W,), DEEPNORM_BETA, f32),
        jnp.ones((M_V_W + 2 * M_HEADS + 2 * A_W,), f32), jnp.full((A_W,), DEEPNORM_BETA, f32)])
    w_in = nrm(ks[4], (DEPTH, D_MODEL, PROJ_DIM), D_MODEL ** -0.5) * col_scale
    fg_start = M_QK_W + 2 * M_V_W + M_HEADS
    b_in = nrm(ks[5], (DEPTH, PROJ_DIM), 0.02)
    b_in = b_in.at[:, fg_start:fg_start + M_HEADS].add(jnp.linspace(3.0, 6.0, M_HEADS, dtype=f32))
    conv_w = nrm(ks[6], (DEPTH, CONV_WIDTH, M_QK_W), CONV_WIDTH ** -0.5)
    conv_b = nrm(ks[7], (DEPTH, M_QK_W), 0.02)
    m_norm_g = 1.0 + nrm(ks[8], (DEPTH, M_V_W), 0.02)
    a_norm_g = 1.0 + nrm(ks[9], (DEPTH, A_W), 0.02)
    w_out = nrm(ks[10], (DEPTH, MIX_WIDTH, D_MODEL), DEEPNORM_BETA * MIX_WIDTH ** -0.5)
    ln1_g = 1.0 + nrm(ks[11], (DEPTH, D_MODEL), 0.02)
    ln1_b = nrm(ks[12], (DEPTH, D_MODEL), 0.02)
    router_w = nrm(ks[13], (DEPTH, D_MODEL, N_EXPERTS), D_MODEL ** -0.5)
    router_b = nrm(ks[14], (DEPTH, N_EXPERTS), 0.01)
    w_gu = nrm(ks[15], (DEPTH, N_EXPERTS, D_MODEL, 2 * D_EXPERT), D_MODEL ** -0.5)
    b_gu = nrm(ks[16], (DEPTH, N_EXPERTS, 2 * D_EXPERT), 0.02)
    w_dn = nrm(ks[17], (DEPTH, N_EXPERTS, D_EXPERT, D_MODEL), DEEPNORM_BETA * D_EXPERT ** -0.5)
    b_dn = nrm(ks[18], (DEPTH, N_EXPERTS, D_MODEL), 0.02)
    ln2_g = 1.0 + nrm(ks[19], (DEPTH, D_MODEL), 0.02)
    ln2_b = nrm(ks[20], (DEPTH, D_MODEL), 0.02)
    return {'x': x, 'c': c, 'w_ada': w_ada, 'b_ada': b_ada, 'w_in': w_in, 'b_in': b_in,
            'conv_w': conv_w, 'conv_b': conv_b, 'm_norm_g': m_norm_g, 'a_norm_g': a_norm_g,
            'w_out': w_out, 'ln1_g': ln1_g, 'ln1_b': ln1_b, 'router_w': router_w,
            'router_b': router_b, 'w_gu': w_gu, 'b_gu': b_gu, 'w_dn': w_dn, 'b_dn': b_dn,
            'ln2_g': ln2_g, 'ln2_b': ln2_b}


def reference(x, c, w_ada, b_ada, w_in, b_in, conv_w, conv_b, m_norm_g, a_norm_g, w_out,
              ln1_g, ln1_b, router_w, router_b, w_gu, b_gu, w_dn, b_dn, ln2_g, ln2_b):
    cond = jax.nn.silu(c)
    for l in range(DEPTH):
        mod = cond @ w_ada[l] + b_ada[l]
        sh1, sc1, g1, sh2, sc2, g2 = jnp.split(mod[:, None, :], 6, axis=-1)
        h = x * (1 + sc1) + sh1
        y = token_mixer(h, w_in[l], b_in[l], conv_w[l], conv_b[l], m_norm_g[l], a_norm_g[l], w_out[l])
        x = layer_norm(DEEPNORM_ALPHA * x + (1 + g1) * y, ln1_g[l], ln1_b[l])
        h = x * (1 + sc2) + sh2
        y = moe(h, router_w[l], router_b[l], w_gu[l], b_gu[l], w_dn[l], b_dn[l])
        x = layer_norm(DEEPNORM_ALPHA * x + (1 + g2) * y, ln2_g[l], ln2_b[l])
    return x
```

```cpp
#include <hip/hip_runtime.h>
#include <cstdio>
#include <cstdint>

#ifndef N_LAUNCH_MODE
#define N_LAUNCH_MODE 1
#endif

#define LAS __attribute__((address_space(3)))
#define GAS __attribute__((address_space(1)))
typedef unsigned short bf16_t;
typedef short bf16x8 __attribute__((ext_vector_type(8)));
typedef short s16x4 __attribute__((ext_vector_type(4)));
typedef float f32x2 __attribute__((ext_vector_type(2)));
typedef float f32x4 __attribute__((ext_vector_type(4)));
typedef float f32x16 __attribute__((ext_vector_type(16)));
typedef unsigned u32x2 __attribute__((ext_vector_type(2)));
typedef unsigned u32x4 __attribute__((ext_vector_type(4)));
typedef int i32x4 __attribute__((ext_vector_type(4)));
typedef int i32x2 __attribute__((ext_vector_type(2)));
typedef int i32x8 __attribute__((ext_vector_type(8)));
constexpr float YP_SCALE = 16.0f, YP_INV = 1.0f / 16.0f;
constexpr float WQ_SCALE = 64.0f, WQ_INV = 1.0f / 64.0f;

constexpr int NB = 4, SEQ = 2048, DM = 2048, NTOK = NB * SEQ;
constexpr int NPJ = 6144;
constexpr int PJ_SRC = 6152;
constexpr int NE = 32, TOPK = 4, DFF = 2048;
constexpr int MH = 4, MDV = 256, MDQK = 128, MCH = 64, NCH = SEQ / MCH;
constexpr int AH = 16, ADH = 64;
constexpr float LN_EPS = 1e-5f;
constexpr float DN_ALPHA = 1.189207115002721f;
constexpr float SW_ALPHA = 1.702f, SW_LIMIT = 7.0f;
constexpr float LOG2E = 1.4426950408889634f;
constexpr float ATT_C2 = 0.125f * LOG2E;
constexpr int PC_QM = 0, PC_KM = 512, PC_VM = 1024, PC_OM = 2048, PC_QA = 3072, PC_KA = 4096, PC_VA = 5120;
constexpr int MOD_W = 6 * DM;

constexpr size_t MiB = 1u << 20;
constexpr size_t WS_CTL = 0, CTL_ZERO_BYTES = 131072;
constexpr size_t WS_BIN2 = 2 * MiB;
constexpr size_t WS_BGU2 = 2 * MiB + 65536;
constexpr size_t WS_RWT = 3 * MiB - 262144;
constexpr size_t WS_LIST = 3 * MiB;
constexpr size_t WS_GATE = 4 * MiB;
constexpr size_t WS_GATES = 5 * MiB;
constexpr size_t WS_MSC = 6 * MiB;
constexpr size_t WS_WIN_T = 8 * MiB;
constexpr size_t WS_WOUT_T = 32 * MiB;
constexpr size_t WS_H = 40 * MiB;
constexpr size_t WS_CAT = 72 * MiB;
constexpr size_t WS_PROJ = 104 * MiB;
constexpr size_t WS_QC = 200 * MiB, WS_KC = 208 * MiB;
constexpr size_t WS_U = 216 * MiB;
constexpr size_t WS_CST = 280 * MiB;
constexpr size_t WS_Y1 = 312 * MiB;
constexpr size_t WS_X1 = 376 * MiB;
constexpr size_t WS_ACT = 440 * MiB;
constexpr size_t WS_H2Q = 560 * MiB;
constexpr size_t WS_YP = 600 * MiB;
constexpr size_t WS_WGU_T = 728 * MiB;
constexpr size_t WS_WDN_T = 1240 * MiB;
constexpr size_t WS_END = 1496 * MiB;
constexpr int CW_BAR = 4096;
constexpr int CW_CNT = 16384;
constexpr int CW_MOD = 65536;
static_assert((CW_CNT + 64 * NE) * 4 <= (int)CTL_ZERO_BYTES && (CW_MOD + NB * MOD_W) * 4 <= (int)(2 * MiB), "ctl");

constexpr int RING_BYTES = 131072;
constexpr int RT_OFF = RING_BYTES, RT_SLOTS = 12, RT_BYTES = RT_SLOTS * 2048;
constexpr int UD_OFF = RT_OFF + RT_BYTES;
constexpr int MISC_OFF = UD_OFF + 1024;
constexpr int BIAS_OFF = MISC_OFF + 256;
constexpr int LDS_BYTES = BIAS_OFF + 2048;
static_assert(LDS_BYTES <= 163840, "LDS");

__device__ __forceinline__ unsigned f2bf(float f) { unsigned u = __builtin_bit_cast(unsigned, f); return (u + 0x7fffu + ((u >> 16) & 1u)) >> 16; }
__device__ __forceinline__ unsigned pk2(float lo, float hi) { return f2bf(lo) | (f2bf(hi) << 16); }
__device__ __forceinline__ unsigned pk4_fp8(float a, float b, float c, float d) { unsigned w = 0u; w = (unsigned)__builtin_amdgcn_cvt_pk_fp8_f32(a, b, (int)w, false); w = (unsigned)__builtin_amdgcn_cvt_pk_fp8_f32(c, d, (int)w, true); return w; }
__device__ __forceinline__ float bf2f(unsigned short b) { return __builtin_bit_cast(float, ((unsigned)b) << 16); }
__device__ __forceinline__ float bflo(unsigned w) { return __builtin_bit_cast(float, w << 16); }
__device__ __forceinline__ float bfhi(unsigned w) { return __builtin_bit_cast(float, w & 0xffff0000u); }
__device__ __forceinline__ float wave_sum(float v) {
#pragma unroll
    for (int o = 1; o < 64; o <<= 1) v += __shfl_xor(v, o);
    return v;
}
__device__ __forceinline__ float wave_max(float v) {
#pragma unroll
    for (int o = 1; o < 64; o <<= 1) v = fmaxf(v, __shfl_xor(v, o));
    return v;
}
#define LDS_WAIT() asm volatile("s_waitcnt lgkmcnt(0)" ::: "memory")
#define VM_WAIT() asm volatile("s_waitcnt vmcnt(0)" ::: "memory")

#define XB_TMO      128
#define XB_XCNT(j)  (256  + 64 * (j))
#define XB_XSUB(j)  (1280 + 64 * (j))
#define XB_XGEN(j)  (2304 + 64 * (j))
#define XB_TOP      3328
#define XB_TOPGEN   3392
#define XCD_BAR_WORDS 3456
#define XB_SPIN_CAP (1u << 18)
__device__ __forceinline__ unsigned xb_ld(unsigned* p)              { return __hip_atomic_load(p, __ATOMIC_RELAXED, __HIP_MEMORY_SCOPE_AGENT); }
__device__ __forceinline__ unsigned xb_add(unsigned* p, unsigned v) { return __hip_atomic_fetch_add(p, v, __ATOMIC_RELAXED, __HIP_MEMORY_SCOPE_AGENT); }
__device__ __forceinline__ unsigned xb_xcc_id() { return (unsigned)__builtin_amdgcn_s_getreg((3 << 11) | 20) & 0xFu; }
#define XB_SPIN(cond, bar) do { unsigned _sp = 0; while (cond) { __builtin_amdgcn_s_sleep(1); \
    if ((++_sp & 255u) == 0u) { if (xb_ld(&(bar)[XB_TMO])) break; if (_sp > XB_SPIN_CAP) { atomicAdd(&(bar)[XB_TMO], 1u); break; } } } } while (0)
struct XcdBarrier { unsigned* bar; unsigned x; volatile LAS unsigned* st; };
__device__ __forceinline__ XcdBarrier xcd_barrier_post(unsigned* bar, volatile LAS unsigned* st) {
    XcdBarrier b; b.bar = bar; b.x = xb_xcc_id(); b.st = st;
    if (threadIdx.x == 0) (void)xb_add(&bar[XB_XCNT(b.x)], 1u);
    return b;
}
__device__ __forceinline__ void xcd_barrier_complete(unsigned* bar, unsigned x, unsigned& nloc, unsigned& nx) {
    const unsigned G = gridDim.x * gridDim.y * gridDim.z;
    unsigned sum, cnt, mine, sp = 0u;
    for (;;) {
        sum = 0u; cnt = 0u; mine = 0u;
#pragma unroll
        for (unsigned j = 0; j < 16; ++j) { const unsigned c = xb_ld(&bar[XB_XCNT(j)]); sum += c; cnt += (c > 0u) ? 1u : 0u; mine = (j == x) ? c : mine; }
        if (sum == G) break;
        __builtin_amdgcn_s_sleep(1);
        if ((++sp & 255u) == 0u) { if (xb_ld(&bar[XB_TMO])) break; if (sp > XB_SPIN_CAP) { atomicAdd(&bar[XB_TMO], 1u); break; } }
    }
    nloc = mine > 0u ? mine : 1u; nx = cnt > 0u ? cnt : 1u;
}
__device__ __forceinline__ void xcd_barrier(const XcdBarrier& b) {
    asm volatile("s_waitcnt vmcnt(0)" ::: "memory");
    __syncthreads();
    if (threadIdx.x == 0) {
        unsigned* bar = b.bar;
        __builtin_amdgcn_s_waitcnt(0);
        unsigned nloc = b.st[0], nx = b.st[1];
        if (nloc == 0u) { xcd_barrier_complete(bar, b.x, nloc, nx); b.st[0] = nloc; b.st[1] = nx; }
        const unsigned old = xb_add(&bar[XB_XSUB(b.x)], 1u);
        const unsigned gen = old / nloc;
        if (old + 1u == (gen + 1u) * nloc) {
            __builtin_amdgcn_fence(__ATOMIC_RELEASE, "agent");
            asm volatile("s_waitcnt vmcnt(0)" ::: "memory");
            const unsigned og = xb_add(&bar[XB_TOP], 1u);
            const unsigned tg = og / nx;
            if (og + 1u == (tg + 1u) * nx) xb_add(&bar[XB_TOPGEN], 1u);
            else XB_SPIN(xb_ld(&bar[XB_TOPGEN]) == tg, bar);
            __builtin_amdgcn_fence(__ATOMIC_ACQUIRE, "agent");
            xb_add(&bar[XB_XGEN(b.x)], 1u);
            asm volatile("s_waitcnt vmcnt(0)" ::: "memory");
        } else {
            XB_SPIN(xb_ld(&bar[XB_XGEN(b.x)]) == gen, bar);
            __builtin_amdgcn_fence(__ATOMIC_ACQUIRE, "agent");
            asm volatile("s_waitcnt vmcnt(0)" ::: "memory");
        }
    }
    __syncthreads();
}

struct Frame {
    LAS unsigned char* lds;
    int wave, G, bx;
    int cgu, cdn, cgrp;
    unsigned char* ws;
    const float* const* in;
    float* const* outp;
};
__device__ __forceinline__ int tid_id() { int t = threadIdx.x; asm volatile("" : "+v"(t)); return t; }
__device__ __forceinline__ int lane_id() { return tid_id() & 63; }
__device__ __forceinline__ int opq(int k) { asm volatile("" : "+s"(k)); return k; }
#define FIN(k) (F.in[opq(k)])
__device__ __forceinline__ void conv_gu(Frame& F, int n);
__device__ __forceinline__ void conv_dn(Frame& F, int n);
enum { I_X = 0, I_C, I_WADA, I_BADA, I_WIN, I_BIN, I_CONVW, I_CONVB, I_MNG, I_ANG, I_WOUT, I_LN1G, I_LN1B, I_RW, I_RB, I_WGU, I_BGU, I_WDN, I_BDN, I_LN2G, I_LN2B };
#define WSP(T, off) ((T*)(F.ws + (off)))

namespace pg8 {
constexpr int BM = 256, BK = 64, HALF = 128, HTB = HALF * BK * 2, STAGE_BYTES = 8 * HTB, NXCD = 8, WGM = 8, KD = 2048;
__host__ __device__ __forceinline__ int lds_byte(int r, int c) { const int st = (r >> 4) * 2 + (c >> 5), rr = r & 15, cc = c & 31, ob = rr * 64 + cc * 2; return st * 1024 + (ob ^ (((ob >> 9) & 1) << 5)); }
__host__ __device__ __forceinline__ void stage_rc(int b, int& R, int& C) { const int st = b / 1024, sb = b % 1024, swz = sb ^ (((sb >> 9) & 1) << 5); R = (st >> 1) * 16 + swz / 64; C = (st & 1) * 32 + (swz % 64) / 2; }
__host__ __device__ __forceinline__ int perm32(int rho) { const int n = rho >> 4, i = rho & 15; return 8 * (i >> 2) + 4 * n + (i & 3); }
struct Unit { int pm, pn, e, slot, half, nh; };
typedef f32x4 Acc[2][2][4][2];

struct StaticOrder {
    int nM, nN, nwg, G, c;
    __device__ void init(int M, int N, int G_, int c_) { nM = M / BM; nN = N / BM; nwg = nM * nN; G = G_; c = c_; }
    __device__ bool next(int i, Unit& u) const {
        const long L = (long)i * G + c; if (L >= nwg) return false;
        int wgid = (int)L; { const int q = nwg / NXCD, r = nwg % NXCD, xcd = wgid % NXCD, off = wgid / NXCD; wgid = (xcd < r ? xcd * (q + 1) : r * (q + 1) + (xcd - r) * q) + off; }
        const int nig = WGM * nN, gid = wgid / nig, fm = gid * WGM, gsz = (nM - fm) < WGM ? (nM - fm) : WGM;
        u.pm = fm + ((wgid % nig) % gsz); u.pn = (wgid % nig) / gsz; u.e = 0; u.slot = 0; u.half = 0; u.nh = 0; return true;
    }
};

template <class PB>
__device__ __forceinline__ void gemm_phase(LAS unsigned char* lds, const PB& P) {
    const int tid = threadIdx.x, wid = __builtin_amdgcn_readfirstlane(tid >> 6), lane = tid & 63, wr = wid >> 2, wc = wid & 3, fr = lane & 15, fq = lane >> 4;
    constexpr int K = KD, PITCH = PB::FP8 ? K : 2 * K, nt = PB::FP8 ? K / 128 : K / BK;
    int Rr[2], Cb[2]; unsigned voffB[2];
#pragma unroll
    for (int i = 0; i < 2; ++i) { int R, C; stage_rc(tid * 16 + i * 8192, R, C); const int Rb = PB::COL16 ? ((R >> 5) * 64 + 16 * ((R & 15) >> 2) + 4 * ((R >> 4) & 1) + (R & 3)) : PB::SWAP16 ? ((R & ~31) + 16 * (((R & 15) >> 2) & 1) + 8 * ((R & 15) >> 3) + 4 * ((R >> 4) & 1) + (R & 3)) : (PB::PERM ? ((R & ~31) + perm32(R & 31)) : R);
        Rr[i] = R; Cb[i] = C * 2; voffB[i] = (unsigned)(Rb * PITCH + C * 2); }
    constexpr size_t kstep = (size_t)(BK * 2);
    constexpr size_t hstep = (size_t)(PB::COL16 ? 8 : HALF) * PITCH;
    const unsigned ldsw = (unsigned)wid * 1024u;
    const int aoff = lds_byte(wr * 64 + fr, fq * 8), boff = lds_byte(wc * 32 + fr, fq * 8);
#define PG8_SA(b, h) (((b) * 2 + (h)) * HTB)
#define PG8_SB(b, h) ((4 + (b) * 2 + (h)) * HTB)
#define PG8_STAGE(bufoff, gbase, voff) do { _Pragma("unroll") for (int _i = 0; _i < 2; ++_i) \
        __builtin_amdgcn_global_load_lds((const unsigned*)((const char*)(gbase) + (voff)[_i]), (LAS unsigned*)(lds + (bufoff) + ldsw + _i * 8192), 16, 0, 0); } while (0)
#define PG8_LD16(off) (*(const LAS i32x4*)(lds + (off)))
#define PG8_LDA(dst, b, h) do { _Pragma("unroll") for (int m = 0; m < 4; ++m) dst[m] = __builtin_shufflevector(PG8_LD16(PG8_SA(b, h) + aoff + m * 2048), PG8_LD16(PG8_SA(b, h) + aoff + m * 2048 + 1024), 0, 1, 2, 3, 4, 5, 6, 7); } while (0)
#define PG8_LDB(dst, b, h) do { _Pragma("unroll") for (int n = 0; n < 2; ++n) dst[n] = __builtin_shufflevector(PG8_LD16(PG8_SB(b, h) + boff + n * 2048), PG8_LD16(PG8_SB(b, h) + boff + n * 2048 + 1024), 0, 1, 2, 3, 4, 5, 6, 7); } while (0)
#define PG8_LO(x) __builtin_bit_cast(bf16x8, __builtin_shufflevector((x), (x), 0, 1, 2, 3))
#define PG8_HI(x) __builtin_bit_cast(bf16x8, __builtin_shufflevector((x), (x), 4, 5, 6, 7))
#define PG8_MMA(ai, bj, At, Bt) do { __builtin_amdgcn_s_setprio(1); _Pragma("unroll") for (int m = 0; m < 4; ++m) _Pragma("unroll") for (int n = 0; n < 2; ++n) { \
        if constexpr (PB::FP8) asm volatile("v_mfma_scale_f32_16x16x128_f8f6f4 %0, %1, %2, %0, %3, %3 op_sel_hi:[0,0,0]" : "+v"(acc[ai][bj][m][n]) : "v"(Bt[n]), "v"(At[m]), "v"(fp8_one)); \
        else { acc[ai][bj][m][n] = __builtin_amdgcn_mfma_f32_16x16x32_bf16(PG8_LO(Bt[n]), PG8_LO(At[m]), acc[ai][bj][m][n], 0, 0, 0); \
               acc[ai][bj][m][n] = __builtin_amdgcn_mfma_f32_16x16x32_bf16(PG8_HI(Bt[n]), PG8_HI(At[m]), acc[ai][bj][m][n], 0, 0, 0); } } \
        __builtin_amdgcn_s_setprio(0); } while (0)
#define PG8_WAIT_V(n) asm volatile("s_waitcnt vmcnt(" #n ")" ::: "memory")
#define PG8_WAIT_L(n) asm volatile("s_waitcnt lgkmcnt(" #n ")" ::: "memory")
#define PG8_BAR __builtin_amdgcn_s_barrier()
#define PG8_SCHED __builtin_amdgcn_sched_barrier(0)
#define PG8_AOFFS(dst, u) do { _Pragma("unroll") for (int h_ = 0; h_ < 2; ++h_) _Pragma("unroll") for (int i_ = 0; i_ < 2; ++i_) dst[h_][i_] = P.a_off(u, h_ * HALF + Rr[i_]) + (unsigned)Cb[i_]; } while (0)
    Unit cur, nxt; int ui = 0;
    if (!P.next(0, cur)) return;
    Acc acc;
#pragma unroll
    for (int a = 0; a < 2; ++a)
#pragma unroll
        for (int b = 0; b < 2; ++b)
#pragma unroll
            for (int m = 0; m < 4; ++m)
#pragma unroll
                for (int n = 0; n < 2; ++n) acc[a][b][m][n] = (f32x4){0.f, 0.f, 0.f, 0.f};
    const unsigned fp8_one = 0x7F7F7F7Fu;
    i32x8 At[4], B0[2], B1[2];
    unsigned vA[2][2], vN[2][2];
    PG8_AOFFS(vA, cur);
    const char* Ab = P.Abase;
    const char* cB = P.b_ptr(cur);
    size_t hsC = P.nfull(cur) ? hstep : 0, hsN = hstep;
    PG8_STAGE(PG8_SB(0, 0), cB, voffB); PG8_STAGE(PG8_SB(0, 1), cB + hsC, voffB); PG8_STAGE(PG8_SA(0, 0), Ab, vA[0]); PG8_STAGE(PG8_SA(0, 1), Ab, vA[1]);
    if (wr == 1) PG8_BAR;
    PG8_WAIT_V(2); PG8_BAR;
    PG8_STAGE(PG8_SB(1, 0), cB + kstep, voffB); PG8_STAGE(PG8_SA(1, 0), Ab + kstep, vA[0]); PG8_STAGE(PG8_SB(1, 1), cB + hsC + kstep, voffB);
    PG8_WAIT_V(6); PG8_BAR;
    for (;;) {
        const bool has_next = P.next(ui + 1, nxt);
        const char* nB = cB;
        if (has_next) { PG8_AOFFS(vN, nxt); nB = P.b_ptr(nxt); hsN = P.nfull(nxt) ? hstep : 0; }
        else {
#pragma unroll
            for (int h_ = 0; h_ < 2; ++h_)
#pragma unroll
                for (int i_ = 0; i_ < 2; ++i_) vN[h_][i_] = vA[h_][i_]; }
        const bool full = P.full(cur), nfull = P.nfull(cur);
        if constexpr (PB::BIAS) { if (wid == 0) __builtin_amdgcn_global_load_lds((const unsigned*)(P.bias_src(cur) + lane * 4), (LAS unsigned*)(lds + BIAS_OFF + (ui & 1) * 1024), 16, 0, 0); }
        for (int t = 0; t < nt; t += 2) {
            const bool last = (t == nt - 2);
            const char* a1 = Ab + (size_t)(t + 1) * kstep;
            const char* a2 = last ? Ab : Ab + (size_t)(t + 2) * kstep; const char* b2 = last ? nB : cB + (size_t)(t + 2) * kstep;
            const char* a3 = a2 + kstep; const char* b3 = b2 + kstep; const size_t hs2 = last ? hsN : hsC;
            unsigned w2[2][2];
#pragma unroll
            for (int h_ = 0; h_ < 2; ++h_)
#pragma unroll
                for (int i_ = 0; i_ < 2; ++i_) w2[h_][i_] = last ? vN[h_][i_] : vA[h_][i_];
            PG8_LDB(B0, 0, 0); if (nfull) PG8_LDB(B1, 0, 1); PG8_SCHED; PG8_LDA(At, 0, 0); PG8_STAGE(PG8_SA(1, 1), a1, vA[1]);
            PG8_WAIT_V(8); PG8_WAIT_L(0); PG8_BAR; PG8_MMA(0, 0, At, B0); if (nfull) PG8_MMA(0, 1, At, B1); PG8_BAR; PG8_SCHED;
            if (full) PG8_LDA(At, 0, 1); PG8_STAGE(PG8_SB(0, 0), b2, voffB); PG8_STAGE(PG8_SB(0, 1), b2 + hs2, voffB); PG8_STAGE(PG8_SA(0, 0), a2, w2[0]);
            PG8_WAIT_V(8); PG8_WAIT_L(0); PG8_BAR; if (full) { PG8_MMA(1, 0, At, B0); if (nfull) PG8_MMA(1, 1, At, B1); } PG8_BAR; PG8_SCHED;
            PG8_LDB(B0, 1, 0); if (nfull) PG8_LDB(B1, 1, 1); PG8_SCHED; PG8_LDA(At, 1, 0); PG8_STAGE(PG8_SA(0, 1), a2, w2[1]);
            PG8_WAIT_V(8); PG8_WAIT_L(0); PG8_BAR; PG8_MMA(0, 0, At, B0); if (nfull) PG8_MMA(0, 1, At, B1); PG8_BAR; PG8_SCHED;
            if (full) PG8_LDA(At, 1, 1); PG8_STAGE(PG8_SB(1, 0), b3, voffB); PG8_STAGE(PG8_SB(1, 1), b3 + hs2, voffB); PG8_STAGE(PG8_SA(1, 0), a3, w2[0]);
            PG8_WAIT_V(8); PG8_WAIT_L(0); PG8_BAR; if (full) { PG8_MMA(1, 0, At, B0); if (nfull) PG8_MMA(1, 1, At, B1); } PG8_BAR; PG8_SCHED;
        }
        if (wr == 0) PG8_BAR;
        if constexpr (PB::FP8) asm volatile("s_nop 15\n\ts_nop 15" ::: "memory");
        P.epi(acc, cur, wr, wc, fr, fq, (const LAS float*)(lds + BIAS_OFF + (ui & 1) * 1024));
        P.hook(ui);
        if (!has_next) break;
#pragma unroll
        for (int a = 0; a < 2; ++a)
#pragma unroll
            for (int b = 0; b < 2; ++b)
#pragma unroll
                for (int m = 0; m < 4; ++m)
#pragma unroll
                    for (int n = 0; n < 2; ++n) acc[a][b][m][n] = (f32x4){0.f, 0.f, 0.f, 0.f};
        cur = nxt; cB = nB; hsC = hsN; ++ui;
#pragma unroll
        for (int h_ = 0; h_ < 2; ++h_)
#pragma unroll
            for (int i_ = 0; i_ < 2; ++i_) vA[h_][i_] = vN[h_][i_];
        if (wr == 1) PG8_BAR;
    }
    PG8_WAIT_V(0);
    PG8_BAR;
#undef PG8_SA
#undef PG8_SB
#undef PG8_STAGE
#undef PG8_LDA
#undef PG8_LDB
#undef PG8_MMA
#undef PG8_LD16
#undef PG8_LO
#undef PG8_HI
#undef PG8_WAIT_V
#undef PG8_WAIT_L
#undef PG8_BAR
#undef PG8_SCHED
#undef PG8_AOFFS
}
__device__ __forceinline__ unsigned cvt_pk_bf16(float lo, float hi) { unsigned r; asm volatile("v_cvt_pk_bf16_f32 %0, %1, %2" : "=v"(r) : "v"(lo), "v"(hi)); return r; }
}

struct PbProj {
    static constexpr bool PERM = true, FP8 = false, COL16 = false, SWAP16 = false;
    const char* Abase; const char* Bt; pg8::StaticOrder S; bf16_t* O; const float* bias; Frame* Fp; int hook_unit, hook_n;
    __device__ __forceinline__ void hook(int ui) const { if (ui == hook_unit) conv_gu(*Fp, hook_n); }
    __device__ __forceinline__ bool next(int i, pg8::Unit& u) const { return S.next(i, u); }
    __device__ __forceinline__ bool full(const pg8::Unit&) const { return true; }
    __device__ __forceinline__ bool nfull(const pg8::Unit&) const { return true; }
    __device__ __forceinline__ unsigned a_off(const pg8::Unit& u, int row) const { return (unsigned)((u.pm * 256 + row) * 2048) * 2u; }
    __device__ __forceinline__ const char* b_ptr(const pg8::Unit& u) const { return Bt + (size_t)u.pn * 256 * 2048 * 2; }
    static constexpr bool BIAS = true;
    __device__ __forceinline__ const float* bias_src(const pg8::Unit& u) const { return bias + u.pn * 256; }
    __device__ __forceinline__ void epi(const pg8::Acc& acc, const pg8::Unit& u, int wr, int wc, int fr, int fq, const LAS float* lb) const {
        const int row0 = u.pm * 256 + wr * 64 + fr, col0 = u.pn * 256 + wc * 32 + 8 * fq;
        const float sc = (u.pn >= PC_QA / 256 && u.pn < PC_KA / 256) ? ATT_C2 : 1.0f;
        f32x4 bv[2][2];
#pragma unroll
        for (int bj = 0; bj < 2; ++bj)
#pragma unroll
            for (int n = 0; n < 2; ++n) bv[bj][n] = *(const LAS f32x4*)(lb + wc * 32 + 8 * fq + bj * 128 + 4 * n) * sc;
#pragma unroll
        for (int ai = 0; ai < 2; ++ai)
#pragma unroll
            for (int m = 0; m < 4; ++m) { bf16_t* rowp = O + (size_t)(row0 + ai * 128 + m * 16) * NPJ + col0;
#pragma unroll
                for (int bj = 0; bj < 2; ++bj) { const f32x4 v0 = acc[ai][bj][m][0] * sc + bv[bj][0], v1 = acc[ai][bj][m][1] * sc + bv[bj][1];
                    u32x4 w; w.x = pg8::cvt_pk_bf16(v0[0], v0[1]); w.y = pg8::cvt_pk_bf16(v0[2], v0[3]); w.z = pg8::cvt_pk_bf16(v1[0], v1[1]); w.w = pg8::cvt_pk_bf16(v1[2], v1[3]);
                    *(u32x4*)(rowp + bj * 128) = w; } }
    }
};
struct PbOut {
    static constexpr bool PERM = true, FP8 = false, COL16 = false, SWAP16 = false;
    const char* Abase; const char* Bt; pg8::StaticOrder S; bf16_t* C;
    __device__ __forceinline__ void hook(int) const {}
    __device__ __forceinline__ bool next(int i, pg8::Unit& u) const { return S.next(i, u); }
    __device__ __forceinline__ bool full(const pg8::Unit&) const { return true; }
    __device__ __forceinline__ bool nfull(const pg8::Unit&) const { return true; }
    __device__ __forceinline__ unsigned a_off(const pg8::Unit& u, int row) const { return (unsigned)((u.pm * 256 + row) * 2048) * 2u; }
    __device__ __forceinline__ const char* b_ptr(const pg8::Unit& u) const { return Bt + (size_t)u.pn * 256 * 2048 * 2; }
    static constexpr bool BIAS = false;
    __device__ __forceinline__ const float* bias_src(const pg8::Unit&) const { return nullptr; }
    __device__ __forceinline__ void epi(const pg8::Acc& acc, const pg8::Unit& u, int wr, int wc, int fr, int fq, const LAS float*) const {
        const int row0 = u.pm * 256 + wr * 64 + fr, col0 = u.pn * 256 + wc * 32 + 8 * fq;
#pragma unroll
        for (int ai = 0; ai < 2; ++ai)
#pragma unroll
            for (int m = 0; m < 4; ++m) { bf16_t* rowp = C + (size_t)(row0 + ai * 128 + m * 16) * DM + col0;
#pragma unroll
                for (int bj = 0; bj < 2; ++bj) { const f32x4 v0 = acc[ai][bj][m][0], v1 = acc[ai][bj][m][1];
                    u32x4 w; w.x = pg8::cvt_pk_bf16(v0[0], v0[1]); w.y = pg8::cvt_pk_bf16(v0[2], v0[3]); w.z = pg8::cvt_pk_bf16(v1[0], v1[1]); w.w = pg8::cvt_pk_bf16(v1[2], v1[3]);
                    *(u32x4*)(rowp + bj * 128) = w; } }
    }
};
struct MoeUnitTab {
    LAS unsigned char* lds; int nun;
    __device__ __forceinline__ bool next(int i, pg8::Unit& u) const {
        if (i >= nun) return false;
        const i32x4 d = *(const LAS i32x4*)(lds + UD_OFF + i * 16);
        u.e = __builtin_amdgcn_readfirstlane(d.x); u.pn = __builtin_amdgcn_readfirstlane(d.y & 0xffff); u.nh = __builtin_amdgcn_readfirstlane(d.y >> 16); u.pm = __builtin_amdgcn_readfirstlane(d.z); u.slot = i;
        const int live = *(const LAS int*)(lds + UD_OFF + 256 + 4 * u.e) - 256 * __builtin_amdgcn_readfirstlane(d.w); u.half = __builtin_amdgcn_readfirstlane(live <= 128 ? 1 : 0); return true;
    }
    __device__ __forceinline__ i32x2 rt(int slot, int row) const { return *(const LAS i32x2*)(lds + RT_OFF + (slot * 256 + row) * 8); }
};
__device__ __forceinline__ float swiglu(float g, float l) {
    const float xg = fminf(g, SW_LIMIT), xl = fminf(fmaxf(l, -SW_LIMIT), SW_LIMIT);
    return xg * __builtin_amdgcn_rcpf(1.0f + __expf(-SW_ALPHA * xg)) * (xl + 1.0f);
}
struct PbGu {
    static constexpr bool PERM = true, FP8 = true, COL16 = false, SWAP16 = true;
    const char* Abase; const char* Wt; MoeUnitTab T; const float* bias; unsigned char* ACT; Frame* Fp; int hook_unit, hook_n;
    __device__ __forceinline__ void hook(int ui) const { if (ui == hook_unit) conv_dn(*Fp, hook_n); }
    __device__ __forceinline__ bool next(int i, pg8::Unit& u) const { return T.next(i, u); }
    __device__ __forceinline__ bool full(const pg8::Unit& u) const { return u.half == 0; }
    __device__ __forceinline__ bool nfull(const pg8::Unit&) const { return true; }
    __device__ __forceinline__ unsigned a_off(const pg8::Unit& u, int row) const { const int dest = T.rt(u.slot, row).x; const int tok = dest < 0 ? 0 : (dest >> 2); return (unsigned)tok * 2048u; }
    __device__ __forceinline__ const char* b_ptr(const pg8::Unit& u) const { return Wt + ((size_t)u.e * 4096 + (size_t)u.pn * 256) * 2048; }
    static constexpr bool BIAS = true;
    __device__ __forceinline__ const float* bias_src(const pg8::Unit& u) const { return bias + (size_t)u.e * 4096 + u.pn * 256; }
    __device__ __forceinline__ void epi(const pg8::Acc& acc, const pg8::Unit& u, int wr, int wc, int fr, int fq, const LAS float* lb) const {
        const int cb = wc * 32 + 16 * (fq & 1) + 8 * (fq >> 1);
        const LAS float* bp = lb + cb;
        f32x4 bg[2], bl[2];
#pragma unroll
        for (int n = 0; n < 2; ++n) { bg[n] = *(const LAS f32x4*)(bp + 4 * n); bl[n] = *(const LAS f32x4*)(bp + 128 + 4 * n); }
        const int acol = u.pn * 128 + wc * 32 + 16 * (fq & 1);
#pragma unroll
        for (int ai = 0; ai < 2; ++ai) {
            if (ai == 1 && u.half) continue;
#pragma unroll
            for (int mp = 0; mp < 4; mp += 2) {
                u32x2 w[2];
#pragma unroll
                for (int k = 0; k < 2; ++k) { const int m = mp + k;
                    const f32x4 g0 = acc[ai][0][m][0] * WQ_INV + bg[0], g1 = acc[ai][0][m][1] * WQ_INV + bg[1], l0 = acc[ai][1][m][0] * WQ_INV + bl[0], l1 = acc[ai][1][m][1] * WQ_INV + bl[1];
                    w[k].x = pk4_fp8(swiglu(g0[0], l0[0]), swiglu(g0[1], l0[1]), swiglu(g0[2], l0[2]), swiglu(g0[3], l0[3]));
                    w[k].y = pk4_fp8(swiglu(g1[0], l1[0]), swiglu(g1[1], l1[1]), swiglu(g1[2], l1[2]), swiglu(g1[3], l1[3])); }
                const auto sx = __builtin_amdgcn_permlane32_swap(w[0].x, w[1].x, false, false), sy = __builtin_amdgcn_permlane32_swap(w[0].y, w[1].y, false, false);
                const int row = u.pm + ai * 128 + wr * 64 + (mp + (fq >> 1)) * 16 + fr;
                *(u32x4*)(ACT + (size_t)row * DFF + acol) = (u32x4){sx[0], sy[0], sx[1], sy[1]}; } }
    }
};
struct PbDn {
    static constexpr bool PERM = true, FP8 = true, COL16 = true, SWAP16 = false;
    const char* Abase; const char* Wt; MoeUnitTab T; const float* bias; unsigned char* YP;
    __device__ __forceinline__ void hook(int) const {}
    __device__ __forceinline__ bool next(int i, pg8::Unit& u) const { return T.next(i, u); }
    __device__ __forceinline__ bool full(const pg8::Unit& u) const { return u.half == 0; }
    __device__ __forceinline__ bool nfull(const pg8::Unit& u) const { return u.nh == 0; }
    __device__ __forceinline__ unsigned a_off(const pg8::Unit& u, int row) const { return (unsigned)(u.pm + row) * 2048u; }
    __device__ __forceinline__ const char* b_ptr(const pg8::Unit& u) const { return Wt + ((size_t)u.e * 2048 + (size_t)u.pn * 256 + (u.nh == 2 ? 8 : 0)) * 2048; }
    static constexpr bool BIAS = true;
    __device__ __forceinline__ const float* bias_src(const pg8::Unit& u) const { return bias + (size_t)u.e * DM + u.pn * 256; }
    __device__ __forceinline__ void epi(const pg8::Acc& acc, const pg8::Unit& u, int wr, int wc, int fr, int fq, const LAS float* lb) const {
        const int col0 = u.pn * 256 + wc * 64 + 16 * fq + (u.nh == 2 ? 8 : 0);
        const LAS float* bp = lb + wc * 64 + 16 * fq + (u.nh == 2 ? 8 : 0);
        f32x4 bv[2][2];
#pragma unroll
        for (int bj = 0; bj < 2; ++bj)
#pragma unroll
            for (int n = 0; n < 2; ++n) bv[bj][n] = *(const LAS f32x4*)(bp + ((bj == 1 && u.nh) ? 0 : bj * 8) + 4 * n);
#pragma unroll
        for (int ai = 0; ai < 2; ++ai)
#pragma unroll
            for (int m = 0; m < 4; ++m) { const i32x2 de = T.rt(u.slot, ai * 128 + wr * 64 + m * 16 + fr);
                if (de.x >= 0) { const int gbits = de.y; const float gt = __int_as_float(gbits) * YP_SCALE;
                    unsigned char* rowp = YP + (size_t)de.x * DM + col0;
                    u32x4 w;
                    { const f32x4 v0 = (acc[ai][0][m][0] * WQ_INV + bv[0][0]) * gt, v1 = (acc[ai][0][m][1] * WQ_INV + bv[0][1]) * gt; w.x = pk4_fp8(v0[0], v0[1], v0[2], v0[3]); w.y = pk4_fp8(v1[0], v1[1], v1[2], v1[3]); }
                    if (u.nh) *(u32x2*)rowp = (u32x2){w.x, w.y};
                    else { const f32x4 v0 = (acc[ai][1][m][0] * WQ_INV + bv[1][0]) * gt, v1 = (acc[ai][1][m][1] * WQ_INV + bv[1][1]) * gt; w.z = pk4_fp8(v0[0], v0[1], v0[2], v0[3]); w.w = pk4_fp8(v1[0], v1[1], v1[2], v1[3]);
                        *(u32x4*)rowp = w; } } }
    }
};
__device__ __forceinline__ int moe_setup(Frame& F, int nN) {
    const int f_tid = tid_id();
    LAS unsigned char* lds = F.lds;
    LAS int* cnt = (LAS int*)(lds + UD_OFF + 256);
    LAS int* tst = cnt + 32;
    LAS int* nunp = tst + 33;
    if (f_tid < 64) {
        const int e = f_tid & 31;
        const int c = (int)__hip_atomic_load(((unsigned*)F.ws) + CW_CNT + 64 * e, __ATOMIC_RELAXED, __HIP_MEMORY_SCOPE_AGENT);
        int incl = (c + 255) >> 8;
#pragma unroll
        for (int o = 1; o < 32; o <<= 1) { const int t = __shfl_up(incl, o, 32); if (e >= o) incl += t; }
        if (f_tid < 32) { cnt[e] = c; tst[e] = incl - ((c + 255) >> 8); if (e == 31) tst[NE] = incl; }
    }
    __syncthreads();
    {
        const int NU = tst[NE] * nN;
        int lo, hi, rank, W;
        if ((F.G & 7) == 0) { const int x = F.bx & 7; W = F.G >> 3; rank = F.bx >> 3; lo = (int)(((long)NU * x) >> 3); hi = (int)(((long)NU * (x + 1)) >> 3); }
        else { W = F.G; rank = F.bx; lo = 0; hi = NU; }
        const int rounds = (hi - lo) / W, tail = (hi - lo) - rounds * W; const bool split = (nN == 8) && tail > 0 && 2 * tail <= W;
        if (W == 32 && hi - lo <= 512) {
            LAS int* wh = nunp + 1;
            const int L = lo + f_tid, w = f_tid >> 5, p = f_tid & 31; const bool valid = L < hi;
            int e = 0, pn = 0, mi = 0; bool hf = false;
            if (valid) { while (e < NE - 1 && tst[e + 1] * nN <= L) ++e;
                const int rem = L - tst[e] * nN, te = tst[e + 1] - tst[e]; pn = rem / te; mi = rem % te; hf = (cnt[e] - 256 * mi) <= 128; }
            const unsigned long long bm = __ballot(valid && hf);
            const unsigned hm = (unsigned)(bm >> (32 * (w & 1)));
            if (p == 0) wh[w] = __popc(hm);
            if (f_tid == 0) wh[16] = 0;
            __syncthreads();
            if (valid) {
                int h0 = 0; for (int i = 0; i < w; ++i) h0 += wh[i];
                const int nh = __popc(hm), below = __popc(hm & ((1u << p) - 1u));
                bool take; int sub = 0;
                if (w == rounds && split) { take = (rank >> 1) == p && rank < 2 * tail; sub = 1 + (rank & 1); }
                else { int r; if (hf) r = (h0 + below) & 31; else { const int f = p - below, a0 = h0 & 31; r = (a0 + nh <= 32) ? (f < a0 ? f : f + nh) : f + (a0 + nh - 32); } take = (r == rank); }
                if (take) { *(LAS i32x4*)(lds + UD_OFF + w * 16) = (i32x4){e, pn | (sub << 16), 256 * (tst[e] + mi), mi}; if (w == rounds) wh[16] = 1; }
            }
            __syncthreads();
            if (f_tid == 0) *nunp = rounds + wh[16];
        } else if (f_tid == 0) {
            int n = 0;
            for (int i = 0; i < RT_SLOTS; ++i) { int L, sub = 0;
                if (i < rounds) L = lo + rank + i * W;
                else if (i == rounds && split) { if (rank >= 2 * tail) break; L = lo + rounds * W + (rank >> 1); sub = 1 + (rank & 1); }
                else if (i == rounds) { if (rank >= tail) break; L = lo + rounds * W + rank; }
                else break;
                int e = 0; while (e < NE - 1 && tst[e + 1] * nN <= L) ++e;
                const int rem = L - tst[e] * nN, te = tst[e + 1] - tst[e], pn = rem / te, mi = rem % te;
                *(LAS i32x4*)(lds + UD_OFF + i * 16) = (i32x4){e, pn | (sub << 16), 256 * (tst[e] + mi), mi}; ++n; }
            *nunp = n;
        }
    }
    __syncthreads();
    const int nun = *nunp;
    const int* LIST = WSP(const int, WS_LIST); const float* GATE = WSP(const float, WS_GATE);
    {
        constexpr int EPT = RT_SLOTS * 256 / 512;
        const int nent = nun * 256; int dst[EPT]; float gg[EPT];
#pragma unroll
        for (int k = 0; k < EPT; ++k) { const int idx = f_tid + 512 * k; dst[k] = -1;
            if (idx < nent) { const i32x4 d = *(const LAS i32x4*)(lds + UD_OFF + (idx >> 8) * 16); const int pos = d.w * 256 + (idx & 255); if (pos < cnt[d.x]) dst[k] = LIST[d.x * NTOK + pos]; } }
#pragma unroll
        for (int k = 0; k < EPT; ++k) gg[k] = dst[k] >= 0 ? GATE[dst[k]] : 0.f;
#pragma unroll
        for (int k = 0; k < EPT; ++k) { const int idx = f_tid + 512 * k; if (idx < nent) *(LAS i32x2*)(lds + RT_OFF + idx * 8) = (i32x2){dst[k], __builtin_bit_cast(int, gg[k])}; }
    }
    __syncthreads();
    return nun;
}

template <int MODE>
__device__ __forceinline__ void p0_transpose_item(const float* W, int ldw, bf16_t* WT, int k0, int n0, LAS float* scr, int lane) {
    const int src0 = (MODE == 1) ? (n0 >= 3072 ? n0 + 8 : n0) : n0;
#pragma unroll 8
    for (int i = 0; i < 32; ++i) { const int kk = 2 * i + (lane >> 5); scr[kk * 33 + (lane & 31)] = W[(size_t)(k0 + kk) * ldw + src0 + (lane & 31)]; }
    LDS_WAIT(); asm volatile("" ::: "memory");
    const int c = lane & 7;
#pragma unroll
    for (int j = 0; j < 4; ++j) { const int n = (lane >> 3) + 8 * j; const LAS float* s = scr + (8 * c) * 33 + n;
        u32x4 o; o.x = pk2(s[0 * 33], s[1 * 33]); o.y = pk2(s[2 * 33], s[3 * 33]); o.z = pk2(s[4 * 33], s[5 * 33]); o.w = pk2(s[6 * 33], s[7 * 33]);
        int orow;
        if (MODE == 2) { const int col = n0 + n, jj = col >> 1; orow = 256 * (jj >> 7) + (jj & 127) + 128 * (col & 1); } else orow = n0 + n;
        *(u32x4*)(WT + (size_t)orow * 2048 + k0 + 8 * c) = o; }
    LDS_WAIT(); asm volatile("" ::: "memory");
}
template <int MODE>
__device__ __forceinline__ void conv_store(const f32x4 (&v)[16], unsigned char* WT, int k0, int n0, int lane) {
    const int kg = lane & 7, ng = lane >> 3;
#pragma unroll
    for (int i = 0; i < 4; ++i) {
        u32x4 o;
        o.x = pk4_fp8(v[0][i] * WQ_SCALE, v[1][i] * WQ_SCALE, v[2][i] * WQ_SCALE, v[3][i] * WQ_SCALE);
        o.y = pk4_fp8(v[4][i] * WQ_SCALE, v[5][i] * WQ_SCALE, v[6][i] * WQ_SCALE, v[7][i] * WQ_SCALE);
        o.z = pk4_fp8(v[8][i] * WQ_SCALE, v[9][i] * WQ_SCALE, v[10][i] * WQ_SCALE, v[11][i] * WQ_SCALE);
        o.w = pk4_fp8(v[12][i] * WQ_SCALE, v[13][i] * WQ_SCALE, v[14][i] * WQ_SCALE, v[15][i] * WQ_SCALE);
        const int col = n0 + 4 * ng + i; int orow;
        if (MODE == 2) { const int jj = col >> 1; orow = 256 * (jj >> 7) + (jj & 127) + 128 * (col & 1); } else orow = col;
        __builtin_nontemporal_store(o, (u32x4*)(WT + (size_t)orow * 2048 + k0 + 16 * kg)); }
}
__device__ __forceinline__ void conv_load(f32x4 (&v)[16], const float* W, int ldw, int k0, int n0, int lane) {
    const int kg = lane & 7, ng = lane >> 3;
    const float* src = W + (size_t)(k0 + 16 * kg) * ldw + n0 + 4 * ng;
#pragma unroll
    for (int j = 0; j < 16; ++j) v[j] = __builtin_nontemporal_load((const f32x4*)(src + (size_t)j * ldw));
}
constexpr int CV_GU_ITEMS = NE * 16 * 128, CV_DN_ITEMS = NE * 16 * 64;
__device__ __forceinline__ void conv_gu(Frame& F, int n) {
    const int f_lane = lane_id();
    const float* w = FIN(I_WGU); unsigned char* WT = WSP(unsigned char, WS_WGU_T);
    const int NGW = (F.G >> 2) * 8, gw = ((((F.bx >> 5) << 3) | (F.bx & 7)) * 8 + F.wave) + F.cgrp * (CV_GU_ITEMS / 4);
    for (int i = 0; i < n; i += 2) { const int it0 = gw + F.cgu * NGW, it1 = it0 + NGW; if (it1 >= (F.cgrp + 1) * (CV_GU_ITEMS / 4)) break; F.cgu += 2;
        const int e0 = it0 >> 11, q0 = it0 & 2047, e1 = it1 >> 11, q1 = it1 & 2047;
        f32x4 va[16], vb[16];
        conv_load(va, w + (size_t)e0 * DM * 4096, 4096, (q0 >> 7) * 128, (q0 & 127) * 32, f_lane);
        conv_load(vb, w + (size_t)e1 * DM * 4096, 4096, (q1 >> 7) * 128, (q1 & 127) * 32, f_lane);
        conv_store<2>(va, WT + (size_t)e0 * 4096 * 2048, (q0 >> 7) * 128, (q0 & 127) * 32, f_lane);
        conv_store<2>(vb, WT + (size_t)e1 * 4096 * 2048, (q1 >> 7) * 128, (q1 & 127) * 32, f_lane); }
}
__device__ __forceinline__ void conv_dn(Frame& F, int n) {
    const int f_lane = lane_id();
    const float* w = FIN(I_WDN); unsigned char* WT = WSP(unsigned char, WS_WDN_T);
    const int NGW = (F.G >> 2) * 8, gw = ((((F.bx >> 5) << 3) | (F.bx & 7)) * 8 + F.wave) + F.cgrp * (CV_DN_ITEMS / 4);
    for (int i = 0; i < n; i += 2) { const int it0 = gw + F.cdn * NGW, it1 = it0 + NGW; if (it1 >= (F.cgrp + 1) * (CV_DN_ITEMS / 4)) break; F.cdn += 2;
        const int e0 = it0 >> 10, q0 = it0 & 1023, e1 = it1 >> 10, q1 = it1 & 1023;
        f32x4 va[16], vb[16];
        conv_load(va, w + (size_t)e0 * DFF * DM, DM, (q0 >> 6) * 128, (q0 & 63) * 32, f_lane);
        conv_load(vb, w + (size_t)e1 * DFF * DM, DM, (q1 >> 6) * 128, (q1 & 63) * 32, f_lane);
        conv_store<0>(va, WT + (size_t)e0 * DM * 2048, (q0 >> 6) * 128, (q0 & 63) * 32, f_lane);
        conv_store<0>(vb, WT + (size_t)e1 * DM * 2048, (q1 >> 6) * 128, (q1 & 63) * 32, f_lane); }
}
__device__ __forceinline__ void p0_prologue(Frame& F) {
    const int f_tid = tid_id();
    const int f_lane = lane_id();
    const float* in_router_w = FIN(I_RW);
    const float* in_w_ada = FIN(I_WADA);
    const float* in_b_ada = FIN(I_BADA);
    const float* in_w_out = FIN(I_WOUT);
    const float* in_w_in = FIN(I_WIN);
    const float* in_b_in = FIN(I_BIN);
    const float* in_w_gu = FIN(I_WGU);
    const float* in_b_gu = FIN(I_BGU);
    const float* in_w_dn = FIN(I_WDN);
    const float* in_c = FIN(I_C);
    LAS unsigned char* lds = F.lds;
    {
        LAS float* sil = (LAS float*)lds;
        LAS float* red = (LAS float*)(lds + 32768);
        for (int i = f_tid; i < NB * DM; i += 512) { const float v = in_c[i]; sil[i] = v / (1.0f + __expf(-v)); }
        __syncthreads();
        float* MOD = (float*)(((unsigned*)F.ws) + CW_MOD);
        const int cg = f_tid % 12, ks = f_tid / 12;
        for (int it = F.bx; it < MOD_W / 48; it += F.G) {
            const int col0 = it * 48;
            f32x4 a[NB];
#pragma unroll
            for (int b = 0; b < NB; ++b) a[b] = (f32x4){0.f, 0.f, 0.f, 0.f};
            if (ks < 42) {
#pragma unroll 4
                for (int row = ks; row < DM; row += 42) {
                    const f32x4 w = __builtin_nontemporal_load((const f32x4*)(in_w_ada + (size_t)row * MOD_W + col0 + cg * 4));
#pragma unroll
                    for (int b = 0; b < NB; ++b) a[b] += w * sil[b * DM + row]; }
#pragma unroll
                for (int b = 0; b < NB; ++b) *(LAS f32x4*)(red + (ks * NB + b) * 48 + cg * 4) = a[b];
            }
            __syncthreads();
            if (f_tid < NB * 48) { const int b = f_tid / 48, cc = f_tid % 48; float sum = in_b_ada[col0 + cc];
                for (int q = 0; q < 42; ++q) sum += red[(q * NB + b) * 48 + cc];
                MOD[b * MOD_W + col0 + cc] = sum; }
            __syncthreads();
        }
    }
    {
        const int gt = F.bx * 512 + f_tid, NT_ = F.G * 512;
        float* BIN2 = WSP(float, WS_BIN2); float* BGU2 = WSP(float, WS_BGU2); bf16_t* RWT = WSP(bf16_t, WS_RWT);
        for (int i = gt; i < NPJ; i += NT_) BIN2[i] = in_b_in[i >= 3072 ? i + 8 : i];
        for (int i = gt; i < NE * 4096; i += NT_) { const int e = i >> 12, w = i & 4095, pn = w >> 8, q = w & 255, j = pn * 128 + (q & 127); BGU2[i] = in_b_gu[(size_t)e * 4096 + 2 * j + (q >> 7)]; }
        for (int i = gt; i < NE * DM; i += NT_) { const int e = i >> 11, d = i & 2047; RWT[i] = (bf16_t)f2bf(in_router_w[(size_t)d * NE + e]); }
    }
    {
        LAS float* scr = (LAS float*)(lds + F.wave * 8448);
        const int gw = F.bx * 8 + F.wave, NGW = F.G * 8;
        constexpr int I_IN = 32 * (NPJ / 32), I_OUT = 32 * (DM / 32);
        constexpr int NITEMS = I_IN + I_OUT;
        bf16_t* WIN_T = WSP(bf16_t, WS_WIN_T); bf16_t* WOUT_T = WSP(bf16_t, WS_WOUT_T);
        for (int it = gw; it < NITEMS; it += NGW) {
            int r = it;
            if (r < I_IN) { const int nb = r % (NPJ / 32), kb = r / (NPJ / 32); p0_transpose_item<1>(in_w_in, PJ_SRC, WIN_T, kb * 64, nb * 32, scr, f_lane); continue; } r -= I_IN;
            { const int nb = r % (DM / 32), kb = r / (DM / 32); p0_transpose_item<0>(in_w_out, DM, WOUT_T, kb * 64, nb * 32, scr, f_lane); }
        }
    }
}

__device__ __forceinline__ void p1_modulate(Frame& F) {
    const int f_tid = tid_id();
    const int f_lane = lane_id();
    const float* in_w_in = FIN(I_WIN);
    const float* in_b_in = FIN(I_BIN);
    const float* in_x = FIN(I_X);
    LAS float* wg = (LAS float*)F.lds;
    for (int i = f_tid; i < DM * 2; i += 512) { const int d = i >> 1, hf = i & 1; const f32x4 v = *(const f32x4*)(in_w_in + (size_t)d * PJ_SRC + 3072 + hf * 4);
#pragma unroll
        for (int q = 0; q < 4; ++q) wg[(hf * 4 + q) * DM + d] = v[q]; }
    __syncthreads();
    const float* MOD = (const float*)(((unsigned*)F.ws) + CW_MOD);
    bf16_t* H = WSP(bf16_t, WS_H); float* GATES = WSP(float, WS_GATES);
    const int gw = F.bx * 8 + F.wave, NGW = F.G * 8;
    for (int m = gw; m < NTOK; m += NGW) {
        const int b = m / SEQ;
        const float* xr = in_x + (size_t)m * DM; const float* sh = MOD + b * MOD_W; const float* sc = sh + DM;
        float g[8];
#pragma unroll
        for (int q = 0; q < 8; ++q) g[q] = 0.f;
#pragma unroll 2
        for (int j = 0; j < 8; ++j) { const int d = 256 * j + 4 * f_lane;
            const f32x4 xv = *(const f32x4*)(xr + d), s1 = *(const f32x4*)(sc + d), h1 = *(const f32x4*)(sh + d);
            const f32x4 hv = xv * (s1 + 1.0f) + h1;
            u32x2 o; o.x = pk2(hv[0], hv[1]); o.y = pk2(hv[2], hv[3]);
            *(u32x2*)(H + (size_t)m * DM + d) = o;
#pragma unroll
            for (int q = 0; q < 8; ++q) { const f32x4 w = *(const LAS f32x4*)(wg + q * DM + d); g[q] += (hv[0] * w[0] + hv[1] * w[1]) + (hv[2] * w[2] + hv[3] * w[3]); } }
#pragma unroll
        for (int q = 0; q < 8; ++q) g[q] = wave_sum(g[q]);
        if (f_lane < 8) { float v = g[0];
#pragma unroll
            for (int q = 1; q < 8; ++q) v = (f_lane == q) ? g[q] : v;
            GATES[(size_t)m * 8 + f_lane] = v + in_b_in[3072 + f_lane]; }
    }
}

__device__ __forceinline__ void p7_ln1_router(Frame& F) {
    const int f_tid = tid_id();
    const int f_lane = lane_id();
    const float* in_router_b = FIN(I_RB);
    const float* in_ln1_g = FIN(I_LN1G);
    const float* in_ln1_b = FIN(I_LN1B);
    const float* in_x = FIN(I_X);
    const float* MOD = (const float*)(((unsigned*)F.ws) + CW_MOD);
    const bf16_t* Y1 = WSP(const bf16_t, WS_Y1); bf16_t* X1 = WSP(bf16_t, WS_X1); unsigned char* H2Q = WSP(unsigned char, WS_H2Q);
    const bf16_t* RWT = WSP(const bf16_t, WS_RWT); int* LIST = WSP(int, WS_LIST); float* GATE = WSP(float, WS_GATE);
    LAS float* part = (LAS float*)F.lds;
    constexpr int H2P = DM + 8;
    LAS bf16_t* h2t = (LAS bf16_t*)F.lds;
    const int r32 = f_lane & 31, hi = f_lane >> 5;
    for (int it = F.bx; it < NTOK / 32; it += F.G) {
        const int t0 = it * 32, b = t0 / SEQ;
        const float* mb = MOD + b * MOD_W;
        u32x2 ywA[8], ywB[8]; f32x4 xvA[8], xvB[8];
#define P7_LOAD(YW, XV, rr_) do { const int m_ = t0 + F.wave * 4 + (rr_); _Pragma("unroll") for (int j = 0; j < 8; ++j) { const int d = 256 * j + 4 * f_lane; \
            YW[j] = __builtin_nontemporal_load((const u32x2*)(Y1 + (size_t)m_ * DM + d)); XV[j] = __builtin_nontemporal_load((const f32x4*)(in_x + (size_t)m_ * DM + d)); } } while (0)
#define P7_TOKEN(YW, XV, rr_) do { const int rr = (rr_), m = t0 + F.wave * 4 + rr; int fl_ = f_lane; asm volatile("" : "+v"(fl_));   \
            f32x4 v[8]; float s = 0.f; \
            _Pragma("unroll") for (int j = 0; j < 8; ++j) { const int d = 256 * j + 4 * fl_; \
                const f32x4 yv = (f32x4){bflo(YW[j].x), bfhi(YW[j].x), bflo(YW[j].y), bfhi(YW[j].y)}, g1 = *(const f32x4*)(mb + 2 * DM + d); \
                v[j] = XV[j] * DN_ALPHA + (g1 + 1.0f) * yv; s += (v[j][0] + v[j][1]) + (v[j][2] + v[j][3]); } \
            const float mean = wave_sum(s) * (1.0f / DM); float s2 = 0.f; \
            _Pragma("unroll") for (int j = 0; j < 8; ++j) { v[j] = v[j] - mean; s2 += (v[j][0] * v[j][0] + v[j][1] * v[j][1]) + (v[j][2] * v[j][2] + v[j][3] * v[j][3]); } \
            const float rstd = 1.0f / sqrtf(wave_sum(s2) * (1.0f / DM) + LN_EPS); \
            _Pragma("unroll") for (int j = 0; j < 8; ++j) { const int d = 256 * j + 4 * fl_; \
                const f32x4 gg = *(const f32x4*)(in_ln1_g + d), bb = *(const f32x4*)(in_ln1_b + d), sc2 = *(const f32x4*)(mb + 4 * DM + d), sh2 = *(const f32x4*)(mb + 3 * DM + d); \
                const f32x4 x1 = v[j] * rstd * gg + bb; \
                { u32x2 xo; xo.x = pk2(x1[0], x1[1]); xo.y = pk2(x1[2], x1[3]); *(u32x2*)(X1 + (size_t)m * DM + d) = xo; } \
                const f32x4 h2 = x1 * (sc2 + 1.0f) + sh2; \
                u32x2 o; o.x = pk2(h2[0], h2[1]); o.y = pk2(h2[2], h2[3]); \
                *(LAS u32x2*)(h2t + (F.wave * 4 + rr) * H2P + d) = o; \
                *(unsigned*)(H2Q + (size_t)m * DM + d) = pk4_fp8(h2[0], h2[1], h2[2], h2[3]); } } while (0)
        P7_LOAD(ywA, xvA, 0);
#pragma unroll 1
        for (int rp = 0; rp < 4; rp += 2) {
            P7_LOAD(ywB, xvB, rp + 1);
            P7_TOKEN(ywA, xvA, rp);
            if (rp + 2 < 4) P7_LOAD(ywA, xvA, rp + 2);
            P7_TOKEN(ywB, xvB, rp + 1);
        }
#undef P7_LOAD
#undef P7_TOKEN
        __syncthreads();
        {
            f32x16 acc = {};
            const LAS bf16_t* ap = h2t + r32 * H2P + F.wave * 256 + hi * 8;
            const bf16_t* bp = RWT + (size_t)r32 * DM + F.wave * 256 + hi * 8;
#pragma unroll
            for (int s = 0; s < 16; ++s) { const bf16x8 a = *(const LAS bf16x8*)(ap + 16 * s), bq = *(const bf16x8*)(bp + 16 * s);
                acc = __builtin_amdgcn_mfma_f32_32x32x16_bf16(a, bq, acc, 0, 0, 0); }
            __syncthreads();
#pragma unroll
            for (int i = 0; i < 16; ++i) { const int tok = (i & 3) + 8 * (i >> 2) + 4 * hi; part[(F.wave * 32 + tok) * 33 + r32] = acc[i]; }
        }
        __syncthreads();
        if (f_tid < 32) {
            float lg[NE];
#pragma unroll
            for (int e = 0; e < NE; ++e) { float s = in_router_b[e];
#pragma unroll
                for (int w = 0; w < 8; ++w) s += part[(w * 32 + f_tid) * 33 + e];
                lg[e] = s; }
            float tv[TOPK]; int ti[TOPK];
#pragma unroll
            for (int k = 0; k < TOPK; ++k) { float best = -INFINITY; int bi = 0;
#pragma unroll
                for (int e = 0; e < NE; ++e) { const bool tk = lg[e] > best; best = tk ? lg[e] : best; bi = tk ? e : bi; }
                tv[k] = best; ti[k] = bi;
#pragma unroll
                for (int e = 0; e < NE; ++e) lg[e] = (e == bi) ? -INFINITY : lg[e]; }
            float ex[TOPK], den = 0.f;
#pragma unroll
            for (int k = 0; k < TOPK; ++k) { ex[k] = __expf(tv[k] - tv[0]); den += ex[k]; }
            const int tok = t0 + f_tid;
            LAS unsigned* ecnt = (LAS unsigned*)(F.lds + UD_OFF);
            ecnt[f_tid] = 0u; LDS_WAIT();
            unsigned lp[TOPK];
#pragma unroll
            for (int k = 0; k < TOPK; ++k) lp[k] = __hip_atomic_fetch_add(ecnt + ti[k], 1u, __ATOMIC_RELAXED, __HIP_MEMORY_SCOPE_WORKGROUP);
            LDS_WAIT();
            const unsigned mine = ecnt[f_tid];
            const unsigned base = mine ? xb_add(((unsigned*)F.ws) + CW_CNT + 64 * f_tid, mine) : 0u;
            LDS_WAIT(); ecnt[f_tid] = base; LDS_WAIT();
#pragma unroll
            for (int k = 0; k < TOPK; ++k) { const int pos = (int)(ecnt[ti[k]] + lp[k]);
                LIST[ti[k] * NTOK + pos] = tok * 4 + k; GATE[tok * 4 + k] = ex[k] / den; }
        }
        __syncthreads();
    }
}

__device__ __forceinline__ void p10_ln2(Frame& F) {
    const int f_lane = lane_id();
    const float* in_ln2_g = FIN(I_LN2G);
    const float* in_ln2_b = FIN(I_LN2B);
    const float* MOD = (const float*)(((unsigned*)F.ws) + CW_MOD);
    const bf16_t* X1 = WSP(const bf16_t, WS_X1); const unsigned char* YP = WSP(const unsigned char, WS_YP);
    float* outp = F.outp[opq(0)];
    const int gw = F.bx * 8 + F.wave, NGW = F.G * 8;
    for (int m = gw; m < NTOK; m += NGW) {
        const int b = m / SEQ; const float* mb = MOD + b * MOD_W;
        f32x4 v[8]; float s = 0.f;
#pragma unroll
        for (int j = 0; j < 8; ++j) { const int d = 256 * j + 4 * f_lane;
            f32x4 y = {0.f, 0.f, 0.f, 0.f};
#pragma unroll
            for (int k = 0; k < TOPK; ++k) { const unsigned w = __builtin_nontemporal_load((const unsigned*)(YP + (size_t)(m * 4 + k) * DM + d)); const f32x2 lo = __builtin_amdgcn_cvt_pk_f32_fp8((int)w, false), hi2 = __builtin_amdgcn_cvt_pk_f32_fp8((int)w, true); y[0] += lo[0]; y[1] += lo[1]; y[2] += hi2[0]; y[3] += hi2[1]; }
            y = y * YP_INV;
            const u32x2 xw = __builtin_nontemporal_load((const u32x2*)(X1 + (size_t)m * DM + d)); const f32x4 xv = (f32x4){bflo(xw.x), bfhi(xw.x), bflo(xw.y), bfhi(xw.y)}, g2 = *(const f32x4*)(mb + 5 * DM + d);
            v[j] = xv * DN_ALPHA + (g2 + 1.0f) * y; s += (v[j][0] + v[j][1]) + (v[j][2] + v[j][3]); }
        const float mean = wave_sum(s) * (1.0f / DM); float s2 = 0.f;
#pragma unroll
        for (int j = 0; j < 8; ++j) { v[j] = v[j] - mean; s2 += (v[j][0] * v[j][0] + v[j][1] * v[j][1]) + (v[j][2] * v[j][2] + v[j][3] * v[j][3]); }
        const float rstd = 1.0f / sqrtf(wave_sum(s2) * (1.0f / DM) + LN_EPS);
#pragma unroll
        for (int j = 0; j < 8; ++j) { const int d = 256 * j + 4 * f_lane;
            const f32x4 gg = *(const f32x4*)(in_ln2_g + d), bb = *(const f32x4*)(in_ln2_b + d);
            __builtin_nontemporal_store(v[j] * rstd * gg + bb, (f32x4*)(outp + (size_t)m * DM + d)); }
    }
}

namespace attn_body {
constexpr int D = 64, PQ = NPJ, PO = DM;
constexpr int NW = 8, QBLK = 32, QB = QBLK * NW, KVBLK = 64, NQB = SEQ / QB;
__device__ __forceinline__ int crow(int r, int hi) { return (r & 3) + 8 * (r >> 2) + 4 * hi; }
#define SBAR() __builtin_amdgcn_sched_barrier(0)
__device__ __forceinline__ float bias1(int d, float s2) {
    const int cnt = (int)((unsigned)d <= 128u) + (int)(((d & 3) == 0) & ((unsigned)d <= 512u)) + (int)(((d & 15) == 0) & (d >= 0));
    const float lm = cnt == 0 ? -INFINITY : (cnt == 1 ? 0.f : (cnt == 2 ? 1.f : 1.5849625007f));
    return lm - s2 * (float)d;
}
constexpr int ABT_N = 2304, ABT_OFF = 256;
constexpr int ABT_COPY = ABT_N * 4 + 64;
__device__ __forceinline__ void abias_tab(f32x16& p0, f32x16& p1, unsigned ta  , float mh) {
    f32x4 q[8];
    asm volatile("ds_read_b128 %0, %8 offset:0\n\tds_read_b128 %1, %8 offset:32\n\tds_read_b128 %2, %8 offset:64\n\tds_read_b128 %3, %8 offset:96\n\t"
                 "ds_read_b128 %4, %8 offset:128\n\tds_read_b128 %5, %8 offset:160\n\tds_read_b128 %6, %8 offset:192\n\tds_read_b128 %7, %8 offset:224\n\ts_waitcnt lgkmcnt(0)"
                 : "=&v"(q[0]), "=&v"(q[1]), "=&v"(q[2]), "=&v"(q[3]), "=&v"(q[4]), "=&v"(q[5]), "=&v"(q[6]), "=&v"(q[7]) : "v"(ta) : "memory");
#pragma unroll
    for (int g = 0; g < 4; ++g)
#pragma unroll
        for (int i = 0; i < 4; ++i) { p0[4 * g + i] += q[g][i] - mh; p1[4 * g + i] += q[4 + g][i] - mh; }
}
constexpr int NSLOT = 3, SLOTB = 8192;
constexpr int LDS_K = 0, LDS_V = NSLOT * SLOTB, LDS_WS = 2 * NSLOT * SLOTB, LDS_OST = LDS_WS + NW * 64 * 4, LDS_TAB = LDS_OST + NW * 4096, LDS_BYTES_A = LDS_TAB + 4 * (2304 * 4 + 64);
__device__ __forceinline__ void glds16(const void* sbase, unsigned voff, unsigned lds_dst) { unsigned keep;
    asm volatile("s_mov_b32 %0, m0\n\ts_mov_b32 m0, %3\n\ts_nop 0\n\tglobal_load_lds_dwordx4 %1, %2\n\ts_mov_b32 m0, %0" : "=&s"(keep) : "v"(voff), "s"(sbase), "s"(lds_dst) : "memory"); }
__device__ __forceinline__ float max3f(float a, float b, float c) { float r; asm("v_max3_f32 %0, %1, %2, %3" : "=v"(r) : "v"(a), "v"(b), "v"(c)); return r; }
__device__ __forceinline__ float max2f(float a, float b) { float r; asm("v_max_f32_e32 %0, %1, %2" : "=v"(r) : "v"(a), "v"(b)); return r; }
__device__ __forceinline__ float fadd_s(float a, float b) { float r; asm("v_add_f32_e32 %0, %1, %2" : "=v"(r) : "v"(a), "v"(b)); return r; }
__device__ __forceinline__ float fsub_s(float a, float b) { float r; asm("v_sub_f32_e32 %0, %1, %2" : "=v"(r) : "v"(a), "v"(b)); return r; }
typedef __bf16 bf16x2_t __attribute__((ext_vector_type(2)));
__device__ __forceinline__ unsigned cvtpk_s(float lo, float hi) { f32x2 v = {lo, hi}; bf16x2_t b = __builtin_convertvector(v, bf16x2_t); return __builtin_bit_cast(unsigned, b); }
#define WAIT_BAR(N) asm volatile("s_waitcnt vmcnt(" #N ") lgkmcnt(0)\n\ts_barrier" ::: "memory")
__device__ __forceinline__ void qkt(f32x16& p0, f32x16& p1, const char* Kslot, const bf16x8* qr, const f32x16& negm, int r32, int hi) {
    const char* kb = Kslot + hi * 1024 + r32 * 16;
#pragma unroll
    for (int d0 = 0; d0 < 4; ++d0) {
        const bf16x8 b0 = *reinterpret_cast<const bf16x8*>(kb + d0 * 2048);
        const bf16x8 b1 = *reinterpret_cast<const bf16x8*>(kb + d0 * 2048 + 512);
        if (d0 == 0) { p0 = __builtin_amdgcn_mfma_f32_32x32x16_bf16(b0, qr[0], negm, 0, 0, 0); p1 = __builtin_amdgcn_mfma_f32_32x32x16_bf16(b1, qr[0], negm, 0, 0, 0); }
        else { p0 = __builtin_amdgcn_mfma_f32_32x32x16_bf16(b0, qr[d0], p0, 0, 0, 0); p1 = __builtin_amdgcn_mfma_f32_32x32x16_bf16(b1, qr[d0], p1, 0, 0, 0); } }
}
typedef __attribute__((address_space(3))) const char* lds_cptr;
typedef short v4i16_t __attribute__((ext_vector_type(4)));
__device__ __forceinline__ void kload8(bf16x8* kf, lds_cptr kp) {
    kf[0] = *(const LAS bf16x8*)(kp);        kf[1] = *(const LAS bf16x8*)(kp + 512);
    kf[2] = *(const LAS bf16x8*)(kp + 2048); kf[3] = *(const LAS bf16x8*)(kp + 2560);
    kf[4] = *(const LAS bf16x8*)(kp + 4096); kf[5] = *(const LAS bf16x8*)(kp + 4608);
    kf[6] = *(const LAS bf16x8*)(kp + 6144); kf[7] = *(const LAS bf16x8*)(kp + 6656);
}
__device__ __forceinline__ void kload2(bf16x8* kf, lds_cptr kp, int j) { kf[2 * j] = *(const LAS bf16x8*)(kp + j * 2048); kf[2 * j + 1] = *(const LAS bf16x8*)(kp + j * 2048 + 512); }
__device__ __forceinline__ s16x4 vtr(lds_cptr p) { return __builtin_bit_cast(s16x4, __builtin_amdgcn_ds_read_tr16_b64_v4i16((LAS v4i16_t*)p)); }
__device__ __forceinline__ float rowmax(const f32x16& p0, const f32x16& p1) {
    float a = max3f(p0[0], p0[1], p1[0]), b = max3f(p0[2], p0[3], p1[1]); a = max3f(a, p1[2], p1[3]);
#pragma unroll
    for (int r = 4; r < 16; r += 4) { a = max3f(a, p0[r], p0[r + 1]); b = max3f(b, p0[r + 2], p0[r + 3]); a = max3f(a, p1[r], p1[r + 1]); b = max3f(b, p1[r + 2], p1[r + 3]); }
    const float m = max2f(a, b);
    auto rr = __builtin_amdgcn_permlane32_swap(__float_as_uint(m), __float_as_uint(m), false, false);
    return max2f(__uint_as_float(rr[0]), __uint_as_float(rr[1]));
}
__device__ __forceinline__ void pv(f32x16* o, int vb, bf16x8 pa0, bf16x8 pa1, bf16x8 pa2, bf16x8 pa3) {
#pragma unroll
    for (int d0 = 0; d0 < 2; ++d0) { s16x4 lo[4], hi[4];
#pragma unroll
        for (int ks = 0; ks < 4; ++ks) {
            asm volatile("ds_read_b64_tr_b16 %0,%1 offset:%c2" : "=&v"(lo[ks]) : "v"(vb), "i"(d0 * 4096 + ks * 1024) : "memory");
            asm volatile("ds_read_b64_tr_b16 %0,%1 offset:%c2" : "=&v"(hi[ks]) : "v"(vb), "i"(d0 * 4096 + ks * 1024 + 512) : "memory"); }
        asm volatile("s_waitcnt lgkmcnt(0)" ::: "memory"); SBAR();
#define PK(k) (bf16x8){lo[k][0], lo[k][1], lo[k][2], lo[k][3], hi[k][0], hi[k][1], hi[k][2], hi[k][3]}
        o[d0] = __builtin_amdgcn_mfma_f32_32x32x16_bf16(pa0, PK(0), o[d0], 0, 0, 0);
        o[d0] = __builtin_amdgcn_mfma_f32_32x32x16_bf16(pa1, PK(1), o[d0], 0, 0, 0);
        o[d0] = __builtin_amdgcn_mfma_f32_32x32x16_bf16(pa2, PK(2), o[d0], 0, 0, 0);
        o[d0] = __builtin_amdgcn_mfma_f32_32x32x16_bf16(pa3, PK(3), o[d0], 0, 0, 0);
#undef PK
    }
}
template <int THRL> __device__ __forceinline__ void attn_unit(int qb, const bf16_t* Qh, const bf16_t* __restrict__ Kh, const bf16_t* __restrict__ Vh, bf16_t* Oh, const float* gn, float slope2, char* shm) {
    const int tid = threadIdx.x; int lane_o = tid & 63; asm volatile("" : "+v"(lane_o));
    const int lane = lane_o, r32 = lane & 31, hi = lane >> 5; const int wid = __builtin_amdgcn_readfirstlane(tid >> 6);
    const int q0 = qb * QB;
    const bf16_t* Qw = Qh + (long)(q0 + wid * QBLK) * PQ;
    const unsigned lds0 = (unsigned)(uintptr_t)shm;
    float* wsf = (float*)(shm + LDS_WS) + wid * 64;
    const unsigned koff = (unsigned)(lane * PQ + wid * 8) * 2u;
    const unsigned voff = (unsigned)((16 * (wid & 3) + (lane >> 2)) * PQ + (wid >> 2) * 32 + (lane & 3) * 8) * 2u;
    const unsigned kdst = lds0 + LDS_K + wid * 1024, vdst = lds0 + LDS_V + wid * 1024;
#define DMA_K(t, slot) glds16(Kh + (long)(t) * KVBLK * PQ, koff, (unsigned)__builtin_amdgcn_readfirstlane(kdst + (slot)))
#define DMA_V(t, slot) glds16(Vh + (long)(t) * KVBLK * PQ, voff, (unsigned)__builtin_amdgcn_readfirstlane(vdst + (slot)))
    const int vb0 = (int)(lds0 + LDS_V) + ((lane >> 4) & 1) * 32 + (lane & 3) * 8 + (4 * hi + ((lane & 15) >> 2)) * 64;
    const char* Kbase = shm + LDS_K; bf16x8 kf[8];
    const lds_cptr shm3 = (lds_cptr)shm; const lds_cptr kp0 = shm3 + LDS_K + hi * 1024 + r32 * 16; const lds_cptr vp0 = shm3 + LDS_V + ((lane >> 4) & 1) * 32 + (lane & 3) * 8 + (4 * hi + ((lane & 15) >> 2)) * 64;
    const int NT = (q0 + QB) / KVBLK;
    DMA_K(0, 0); DMA_V(0, 0); DMA_K(1, SLOTB);
    bf16x8 qr[4];
#pragma unroll
    for (int d0 = 0; d0 < 4; ++d0) qr[d0] = *reinterpret_cast<const bf16x8*>(&Qw[(long)r32 * PQ + d0 * 16 + hi * 8]);
    float mhat = 0.f, l_reg = 0.f; f32x16 o[2]; o[0] = f32x16{}; o[1] = f32x16{}; const f32x16 negm = f32x16{};
    const int e0 = 2047 - (q0 + wid * QBLK + r32 - 4 * hi);
    const unsigned tab0 = lds0 + LDS_TAB + (unsigned)((e0 & 3) * ABT_COPY + 4 * (e0 & ~3));
#define CMASK(P0, P1, t) abias_tab(P0, P1, tab0 + 256u * (unsigned)(t), mhat)
    bool resc = false;
#define START(P0, P1) do { const float rm = rowmax(P0, P1); resc = false; \
    { const float dl = rm; mhat = fadd_s(mhat, dl); \
      _Pragma("unroll") for (int r = 0; r < 16; ++r) { P0[r] = fsub_s(P0[r], dl); P1[r] = fsub_s(P1[r], dl); } } \
    _Pragma("unroll") for (int r = 0; r < 16; ++r) P0[r] = __builtin_amdgcn_exp2f(P0[r]); } while (0)
#define RESC() do { if (resc) { asm volatile("s_waitcnt lgkmcnt(0)" ::: "memory"); \
      _Pragma("unroll") for (int d_ = 0; d_ < 2; ++d_) _Pragma("unroll") for (int r = 0; r < 16; ++r) o[d_][r] *= wsf[crow(r, hi)]; } } while (0)
    f32x16 pA0, pA1, pB0, pB1;
    int sl_prev = 0, sl_cur = 0, sl_next = SLOTB;
#define ROT() do { sl_prev = sl_cur; sl_cur = sl_next; sl_next = (sl_next == (NSLOT - 1) * SLOTB) ? 0 : sl_next + SLOTB; } while (0)
    DMA_K(2, 2 * SLOTB);
    WAIT_BAR(3);
    qkt(pA0, pA1, Kbase, qr, negm, r32, hi); asm volatile("s_nop 15\n\ts_nop 7" : "+v"(pA0), "+v"(pA1)); CMASK(pA0, pA1, 0);
    START(pA0, pA1);
    _Pragma("unroll") for (int r = 0; r < 16; ++r) pA1[r] = __builtin_amdgcn_exp2f(pA1[r]);
    WAIT_BAR(0);
    DMA_K(3, 0); DMA_V(1, SLOTB);
    ROT();
    kload8(kf, kp0 + sl_cur);
    WAIT_BAR(2);
    s16x4 vlo[8], vhi[8]; u32x4 pw0, pw1, pw2, pw3;
#define PKW(P, B) cvtpk_s(P[B], P[B + 1])
#define PAF(k) __builtin_bit_cast(bf16x8, pw##k)
#define VFR(i) (bf16x8){vlo[i][0], vlo[i][1], vlo[i][2], vlo[i][3], vhi[i][0], vhi[i][1], vhi[i][2], vhi[i][3]}
#define PIN(x) asm volatile("" : "+v"(x))
#define MX3(a, b, c) __builtin_fmaxf(__builtin_fmaxf((a), (b)), (c))
#define GAPA(MF, A0, A1, A2, A3, W0, W1, PW) do { MF; sacc += A0; sacc += A1; sacc += A2; sacc += A3; PIN(sacc); W0; W1; PIN(PW); SBAR(); } while (0)
#define EX(v) __builtin_amdgcn_exp2f(v)
#define GAPB(MF, X, B) do { MF; X[B] = EX(X[B]); X[B + 1] = EX(X[B + 1]); X[B + 2] = EX(X[B + 2]); X[B + 3] = EX(X[B + 3]); PIN(X); SBAR(); } while (0)
#define VRD(i) do { vlo[i] = vtr(vp_ + (((i) >> 2) * 4096 + ((i) & 3) * 1024)); vhi[i] = vtr(vp_ + (((i) >> 2) * 4096 + ((i) & 3) * 1024 + 512)); } while (0)
#define KRD(G, j) do { if (G) { kload2(kf, kp0 + sl_next, j); SBAR(); } } while (0)
#define STEP(C0, C1, P0, P1, t, GK, GV, GL, MASKFN) do { SBAR(); \
    const lds_cptr vp_ = vp0 + sl_prev; \
    VRD(0); SBAR(); float sacc = (P0[0] + P0[1]); \
    GAPA(C0 = __builtin_amdgcn_mfma_f32_32x32x16_bf16(kf[0], qr[0], negm, 0, 0, 0), P0[2], P0[3], P0[4], P0[5],     pw0[0] = PKW(P0, 0), pw0[1] = PKW(P0, 2), pw0); \
    VRD(4); SBAR(); GAPA(C1 = __builtin_amdgcn_mfma_f32_32x32x16_bf16(kf[1], qr[0], negm, 0, 0, 0), P0[6], P0[7], P0[8], P0[9],     pw0[2] = PKW(P0, 4), pw0[3] = PKW(P0, 6), pw0); \
    VRD(1); SBAR(); GAPA(C0 = __builtin_amdgcn_mfma_f32_32x32x16_bf16(kf[2], qr[1], C0, 0, 0, 0),   P0[10], P0[11], P0[12], P0[13], pw1[0] = PKW(P0, 8), pw1[1] = PKW(P0, 10), pw1); \
    VRD(5); SBAR(); GAPA(C1 = __builtin_amdgcn_mfma_f32_32x32x16_bf16(kf[3], qr[1], C1, 0, 0, 0),   P0[14], P0[15], P1[0], P1[1],   pw1[2] = PKW(P0, 12), pw1[3] = PKW(P0, 14), pw1); \
    VRD(2); SBAR(); GAPA(C0 = __builtin_amdgcn_mfma_f32_32x32x16_bf16(kf[4], qr[2], C0, 0, 0, 0),   P1[2], P1[3], P1[4], P1[5],     pw2[0] = PKW(P1, 0), pw2[1] = PKW(P1, 2), pw2); \
    VRD(6); SBAR(); GAPA(C1 = __builtin_amdgcn_mfma_f32_32x32x16_bf16(kf[5], qr[2], C1, 0, 0, 0),   P1[6], P1[7], P1[8], P1[9],     pw2[2] = PKW(P1, 4), pw2[3] = PKW(P1, 6), pw2); \
    VRD(3); SBAR(); GAPA(C0 = __builtin_amdgcn_mfma_f32_32x32x16_bf16(kf[6], qr[3], C0, 0, 0, 0),   P1[10], P1[11], P1[12], P1[13], pw3[0] = PKW(P1, 8), pw3[1] = PKW(P1, 10), pw3); \
    VRD(7); SBAR(); GAPA(C1 = __builtin_amdgcn_mfma_f32_32x32x16_bf16(kf[7], qr[3], C1, 0, 0, 0),   P1[14], P1[15], 0.f, 0.f,       pw3[2] = PKW(P1, 12), pw3[3] = PKW(P1, 14), pw3); \
    l_reg += sacc; \
    if (GK) { DMA_K((t) + 3, sl_cur); } if (GV) { DMA_V((t) + 1, sl_next); } \
    MASKFN(C0, C1, t); \
    { float a = MX3(C0[0], C0[1], C1[0]), b = MX3(C0[2], C0[3], C1[1]); a = MX3(a, C1[2], C1[3]); \
      _Pragma("unroll") for (int r = 4; r < 16; r += 4) { a = MX3(a, C0[r], C0[r + 1]); b = MX3(b, C0[r + 2], C0[r + 3]); a = MX3(a, C1[r], C1[r + 1]); b = MX3(b, C1[r + 2], C1[r + 3]); } \
      float rm = __builtin_fmaxf(a, b); { auto rr = __builtin_amdgcn_permlane32_swap(__float_as_uint(rm), __float_as_uint(rm), false, false); rm = __builtin_fmaxf(__uint_as_float(rr[0]), __uint_as_float(rr[1])); } \
      resc = false; \
      if (__builtin_expect(__any(rm > (float)THRL), 0)) { const float dl = __builtin_fmaxf(rm, 0.f); mhat += dl; \
        _Pragma("unroll") for (int r = 0; r < 16; ++r) { C0[r] -= dl; C1[r] -= dl; } \
        const float f = __builtin_amdgcn_exp2f(-dl); l_reg *= f; if (hi == 0) wsf[r32] = f; resc = true; } } \
    SBAR(); \
    GAPB(o[0] = __builtin_amdgcn_mfma_f32_32x32x16_bf16(PAF(0), VFR(0), o[0], 0, 0, 0), C0, 0); \
    GAPB(o[1] = __builtin_amdgcn_mfma_f32_32x32x16_bf16(PAF(0), VFR(4), o[1], 0, 0, 0), C0, 4); \
    KRD(GL, 0); GAPB(o[0] = __builtin_amdgcn_mfma_f32_32x32x16_bf16(PAF(1), VFR(1), o[0], 0, 0, 0), C0, 8); \
    KRD(GL, 1); GAPB(o[1] = __builtin_amdgcn_mfma_f32_32x32x16_bf16(PAF(1), VFR(5), o[1], 0, 0, 0), C0, 12); \
    KRD(GL, 2); GAPB(o[0] = __builtin_amdgcn_mfma_f32_32x32x16_bf16(PAF(2), VFR(2), o[0], 0, 0, 0), C1, 0); \
    KRD(GL, 3); GAPB(o[1] = __builtin_amdgcn_mfma_f32_32x32x16_bf16(PAF(2), VFR(6), o[1], 0, 0, 0), C1, 4); \
    GAPB(o[0] = __builtin_amdgcn_mfma_f32_32x32x16_bf16(PAF(3), VFR(3), o[0], 0, 0, 0), C1, 8); \
    GAPB(o[1] = __builtin_amdgcn_mfma_f32_32x32x16_bf16(PAF(3), VFR(7), o[1], 0, 0, 0), C1, 12); \
    } while (0)
    int t = 1;
    for (; t + 5 < NT; t += 2) {
        STEP(pB0, pB1, pA0, pA1, t, true, true, true, CMASK);     WAIT_BAR(2); RESC(); ROT();
        STEP(pA0, pA1, pB0, pB1, t + 1, true, true, true, CMASK); WAIT_BAR(2); RESC(); ROT();
    }
#define ENDW(tt) do { if ((tt) + 3 < NT) { WAIT_BAR(2); } else if ((tt) + 2 < NT) { WAIT_BAR(1); } else { WAIT_BAR(0); } } while (0)
    for (; t + 1 < NT; t += 2) {
        STEP(pB0, pB1, pA0, pA1, t, (t + 3 < NT), (t + 1 < NT), (t + 1 < NT), CMASK);         ENDW(t);     RESC(); ROT();
        STEP(pA0, pA1, pB0, pB1, t + 1, (t + 4 < NT), (t + 2 < NT), (t + 2 < NT), CMASK);     ENDW(t + 1); RESC(); ROT();
    }
    STEP(pB0, pB1, pA0, pA1, NT - 1, false, false, false, CMASK); RESC();
    { float sacc = pB0[0] + pB0[1]; _Pragma("unroll") for (int r = 2; r < 16; ++r) sacc += pB0[r]; _Pragma("unroll") for (int r = 0; r < 16; ++r) sacc += pB1[r]; l_reg += sacc;
      pw0 = (u32x4){PKW(pB0, 0), PKW(pB0, 2), PKW(pB0, 4), PKW(pB0, 6)}; pw1 = (u32x4){PKW(pB0, 8), PKW(pB0, 10), PKW(pB0, 12), PKW(pB0, 14)}; pw2 = (u32x4){PKW(pB1, 0), PKW(pB1, 2), PKW(pB1, 4), PKW(pB1, 6)}; pw3 = (u32x4){PKW(pB1, 8), PKW(pB1, 10), PKW(pB1, 12), PKW(pB1, 14)};
      SBAR(); pv(o, vb0 + sl_cur, PAF(0), PAF(1), PAF(2), PAF(3)); }
#undef PKW
#undef PAF
#undef VFR
#undef PIN
#undef MX3
#undef GAPA
#undef GAPB
#undef EX
#undef VRD
#undef KRD
#undef STEP
#undef ENDW
    { auto rr = __builtin_amdgcn_permlane32_swap(__float_as_uint(l_reg), __float_as_uint(l_reg), false, false); l_reg = __uint_as_float(rr[0]) + __uint_as_float(rr[1]); }
    if (hi == 0) wsf[32 + r32] = l_reg; asm volatile("s_waitcnt lgkmcnt(0)" ::: "memory");
    float rli[16];
#pragma unroll
    for (int r = 0; r < 16; ++r) rli[r] = __builtin_amdgcn_rcpf(wsf[32 + crow(r, hi)]);
    int lane_e = threadIdx.x & 63; asm volatile("" : "+v"(lane_e));
    const int r32e = lane_e & 31, hie = lane_e >> 5;
    bf16_t* Ow = Oh + (long)(q0 + wid * QBLK) * PO;
    { bf16_t* stg = (bf16_t*)(shm + LDS_OST) + wid * 2048;
#pragma unroll
      for (int r = 0; r < 16; ++r) { const int orow = crow(r, hie);
#pragma unroll
        for (int d0 = 0; d0 < 2; ++d0) stg[orow * 64 + d0 * 32 + r32e] = (bf16_t)f2bf(o[d0][r] * rli[r]); }
      asm volatile("s_waitcnt lgkmcnt(0)" ::: "memory");
#pragma unroll
      for (int i = 0; i < 4; ++i) { const int row = i * 8 + (lane_e >> 3), ch = lane_e & 7; const u32x4 v = *(const u32x4*)(stg + row * 64 + ch * 8);
        float xv[8]; xv[0] = bflo(v.x); xv[1] = bfhi(v.x); xv[2] = bflo(v.y); xv[3] = bfhi(v.y); xv[4] = bflo(v.z); xv[5] = bfhi(v.z); xv[6] = bflo(v.w); xv[7] = bfhi(v.w);
        float ss = 0.f;
#pragma unroll
        for (int j = 0; j < 8; ++j) ss += xv[j] * xv[j];
        ss += __shfl_xor(ss, 1); ss += __shfl_xor(ss, 2); ss += __shfl_xor(ss, 4);
        const float rinv = 1.0f / sqrtf(ss * (1.0f / 64.0f) + LN_EPS);
        const f32x4 g0 = *(const f32x4*)(gn + ch * 8), g1 = *(const f32x4*)(gn + ch * 8 + 4);
        u32x4 w; w.x = pk2(xv[0] * rinv * g0[0], xv[1] * rinv * g0[1]); w.y = pk2(xv[2] * rinv * g0[2], xv[3] * rinv * g0[3]);
        w.z = pk2(xv[4] * rinv * g1[0], xv[5] * rinv * g1[1]); w.w = pk2(xv[6] * rinv * g1[2], xv[7] * rinv * g1[3]);
        *(u32x4*)(Ow + (long)row * PO + ch * 8) = w; } }
    asm volatile("s_waitcnt lgkmcnt(0)\n\ts_barrier" ::: "memory");
#undef DMA_K
#undef DMA_V
#undef CMASK
#undef START
#undef RESC
#undef ROT
}
#undef SBAR
#undef WAIT_BAR
}

__device__ __forceinline__ void p3_attention(Frame& F) {
    const float* in_a_norm_g = FIN(I_ANG);
    const bf16_t* PROJ = WSP(const bf16_t, WS_PROJ); bf16_t* CAT = WSP(bf16_t, WS_CAT);
    const int vcu = ((F.G & 7) == 0) ? (F.bx & 7) * (F.G >> 3) + (F.bx >> 3) : F.bx;
    for (int pr = vcu; pr < NB * AH * 4; pr += F.G) {
        const int bh = pr >> 2, s = pr & 3, b = bh / AH, h = bh % AH;
        const float slope2 = exp2f(-0.5f * (float)(h + 1)) * LOG2E;
        const bf16_t* base = PROJ + (size_t)b * SEQ * NPJ + h * ADH;
        bf16_t* ob = CAT + (size_t)b * SEQ * DM + DM / 2 + h * ADH;
        { LAS float* tab = (LAS float*)(F.lds + attn_body::LDS_TAB);
          for (int i = tid_id(); i < 4 * attn_body::ABT_N; i += 512) { const int k = i / attn_body::ABT_N, j = i - k * attn_body::ABT_N; tab[k * (attn_body::ABT_COPY / 4) + j] = attn_body::bias1(2047 - j - k, slope2); }
          __syncthreads(); }
#pragma unroll 1
        for (int j = 0; j < 2; ++j) {
            attn_body::attn_unit<8>(j ? 7 - s : s, base + PC_QA, base + PC_KA, base + PC_VA, ob, in_a_norm_g + h * ADH, slope2, (char*)F.lds);
            if (j == 0 && F.cgrp == 1) conv_gu(F, 16); }
    }
}

constexpr int ML_PK = 72;
constexpr int ML_PQ = 136;
__device__ __forceinline__ float log_sigmoid(float x) { return fminf(x, 0.f) - log1pf(__expf(-fabsf(x))); }
__device__ __forceinline__ float silu_f(float x) { return x * __builtin_amdgcn_rcpf(1.0f + __expf(-x)); }

__device__ __forceinline__ void mlstm_a_unit(Frame& F, int unit) {
    const int f_tid = tid_id();
    const int f_lane = lane_id();
    const float* in_conv_w = FIN(I_CONVW);
    const float* in_conv_b = FIN(I_CONVB);
    LAS unsigned char* lds = F.lds;
    LAS float* wsv = (LAS float*)lds;
    LAS bf16_t* KT = (LAS bf16_t*)(lds + 1024);
    LAS bf16_t* VT = (LAS bf16_t*)(lds + 1024 + 128 * ML_PK * 2);
    const int bh = unit >> 5, c = unit & 31, b = bh >> 2, h = bh & 3, row0 = b * SEQ + c * MCH;
    const bf16_t* PROJ = WSP(const bf16_t, WS_PROJ); const float* GATES = WSP(const float, WS_GATES);
    bf16_t* QC = WSP(bf16_t, WS_QC); bf16_t* KC = WSP(bf16_t, WS_KC);
    float* MSC = WSP(float, WS_MSC);
    if (F.wave == 0) {
        const int row = row0 + f_lane;
        const float ig = GATES[(size_t)row * 8 + h], fg = GATES[(size_t)row * 8 + 4 + h];
        float bcum = log_sigmoid(fg);
#pragma unroll
        for (int o = 1; o < 64; o <<= 1) { const float t = __shfl_up(bcum, o); if (f_lane >= o) bcum += t; }
        const float bl = __shfl(bcum, 63);
        const float g = bl - bcum + ig; const float mloc = wave_max(g);
        wsv[f_lane] = __expf(g - mloc);
        if (f_lane == 0) { MSC[unit] = bl; MSC[512 + unit] = mloc; }
    }
    __syncthreads();
    {
        const int cp = f_tid & 127, rg = f_tid >> 7, col = 2 * cp, isk = col >> 7, cc = col & 127, pc = isk * 512 + h * 128 + cc;
        f32x2 cw[4];
#pragma unroll
        for (int j = 0; j < 4; ++j) cw[j] = *(const f32x2*)(in_conv_w + j * 1024 + pc);
        const f32x2 cbv = *(const f32x2*)(in_conv_b + pc);
        f32x2 xw[19];
#pragma unroll
        for (int i = 0; i < 19; ++i) { const int tp = c * MCH + rg * 16 + i - 3;
            unsigned w = 0u; if (tp >= 0) w = *(const unsigned*)(PROJ + (size_t)(b * SEQ + tp) * NPJ + pc);
            xw[i] = (f32x2){bflo(w), bfhi(w)}; }
#pragma unroll
        for (int i = 0; i < 16; ++i) { const int s = rg * 16 + i;
            f32x2 y = cbv + cw[0] * xw[i] + cw[1] * xw[i + 1] + cw[2] * xw[i + 2] + cw[3] * xw[i + 3];
            y[0] = silu_f(y[0]); y[1] = silu_f(y[1]);
            if (isk) { y = y * 0.08838834764831845f; const unsigned pw = pk2(y[0], y[1]);
                *(unsigned*)(KC + (size_t)(row0 + s) * 512 + h * 128 + cc) = pw;
                KT[cc * ML_PK + s] = (bf16_t)(pw & 0xffffu); KT[(cc + 1) * ML_PK + s] = (bf16_t)(pw >> 16); }
            else *(unsigned*)(QC + (size_t)(row0 + s) * 512 + h * 128 + cc) = pk2(y[0], y[1]); }
        const int vp = f_tid & 127;
#pragma unroll 4
        for (int i = 0; i < 16; ++i) { const int s = rg * 16 + i; const float w = wsv[s];
            const unsigned x = *(const unsigned*)(PROJ + (size_t)(row0 + s) * NPJ + PC_VM + h * MDV + 2 * vp);
            VT[(2 * vp) * ML_PK + s] = (bf16_t)f2bf(bflo(x) * w); VT[(2 * vp + 1) * ML_PK + s] = (bf16_t)f2bf(bfhi(x) * w); }
    }
    __syncthreads();
    {
        const int r32 = f_lane & 31, hi = f_lane >> 5, w = F.wave;
        f32x16 acc[4];
#pragma unroll
        for (int db = 0; db < 4; ++db) acc[db] = f32x16{};
#pragma unroll
        for (int ks = 0; ks < 4; ++ks) { const bf16x8 a = *(const LAS bf16x8*)(VT + (32 * w + r32) * ML_PK + 16 * ks + 8 * hi);
#pragma unroll
            for (int db = 0; db < 4; ++db) { const bf16x8 bq = *(const LAS bf16x8*)(KT + (32 * db + r32) * ML_PK + 16 * ks + 8 * hi);
                acc[db] = __builtin_amdgcn_mfma_f32_32x32x16_bf16(a, bq, acc[db], 0, 0, 0); } }
        float* U = WSP(float, WS_U) + (size_t)unit * (MDV * MDQK);
#pragma unroll
        for (int db = 0; db < 4; ++db)
#pragma unroll
            for (int i = 0; i < 16; ++i) { const int v = 32 * w + (i & 3) + 8 * (i >> 2) + 4 * hi; U[v * MDQK + 32 * db + r32] = acc[db][i]; }
        if (f_tid < MDQK) { float s = 0.f;
#pragma unroll 8
            for (int q = 0; q < MCH; ++q) s += wsv[q] * bf2f(KT[f_tid * ML_PK + q]);
            MSC[2048 + unit * MDQK + f_tid] = s; }
    }
    __syncthreads();
}
__device__ __forceinline__ void mlstm_b_scan(Frame& F) {
    const int f_tid = tid_id();
    const float* U = WSP(const float, WS_U); bf16_t* CST = WSP(bf16_t, WS_CST); float* MSC = WSP(float, WS_MSC);
    const int gt = F.bx * 512 + f_tid, NTH = F.G * 512;
    for (int idx = gt; idx < 16 * 8192; idx += NTH) {
        const int bh = idx >> 13, off = (idx & 8191) * 4;
        float m = 0.f; f32x4 C = {0.f, 0.f, 0.f, 0.f};
#pragma unroll 4
        for (int c = 0; c < NCH; ++c) { const int un = bh * NCH + c; const size_t base = (size_t)un * (MDV * MDQK) + off;
            u32x2 o; o.x = pk2(C[0], C[1]); o.y = pk2(C[2], C[3]); *(u32x2*)(CST + base) = o;
            if ((idx & 8191) == 0) MSC[1024 + un] = m;
            const float Bc = MSC[un], ml = MSC[512 + un];
            const float mn = fmaxf(Bc + m, ml), dec = __expf(Bc + m - mn), inj = __expf(ml - mn);
            const f32x4 u = __builtin_nontemporal_load((const f32x4*)(U + base));
            C = C * dec + u * inj; m = mn; }
    }
    if (gt < 16 * 32) {
        const int bh = gt >> 5, off = (gt & 31) * 4;
        float m = 0.f; f32x4 n = {0.f, 0.f, 0.f, 0.f};
        for (int c = 0; c < NCH; ++c) { const int un = bh * NCH + c;
            *(f32x4*)(MSC + 2048 + 65536 + un * MDQK + off) = n;
            const float Bc = MSC[un], ml = MSC[512 + un];
            const float mn = fmaxf(Bc + m, ml), dec = __expf(Bc + m - mn), inj = __expf(ml - mn);
            const f32x4 u = *(const f32x4*)(MSC + 2048 + un * MDQK + off);
            n = n * dec + u * inj; m = mn; }
    }
}
__device__ __forceinline__ void mlstm_c_unit(Frame& F, int unit) {
    const int f_tid = tid_id();
    const int f_lane = lane_id();
    const float* in_m_norm_g = FIN(I_MNG);
    LAS unsigned char* lds = F.lds;
    LAS float* su = (LAS float*)lds;
    LAS float* sM = su + 64; LAS float* sbt = su + 128; LAS float* sei = su + 192; LAS float* snq = su + 256; LAS float* sden = su + 320;
    LAS bf16_t* Qs = (LAS bf16_t*)(lds + 2048);
    LAS bf16_t* Ks = (LAS bf16_t*)(lds + 2048 + 64 * ML_PQ * 2);
    LAS bf16_t* VT = (LAS bf16_t*)(lds + 2048 + 2 * 64 * ML_PQ * 2);
    LAS float* Hs = (LAS float*)(lds + 2048);
    const int bh = unit >> 5, c = unit & 31, b = bh >> 2, h = bh & 3, row0 = b * SEQ + c * MCH;
    const bf16_t* PROJ = WSP(const bf16_t, WS_PROJ); const float* GATES = WSP(const float, WS_GATES);
    const bf16_t* QC = WSP(const bf16_t, WS_QC); const bf16_t* KC = WSP(const bf16_t, WS_KC);
    const float* MSC = WSP(const float, WS_MSC); const bf16_t* CST = WSP(const bf16_t, WS_CST) + (size_t)unit * (MDV * MDQK);
    bf16_t* CAT = WSP(bf16_t, WS_CAT);
    if (F.wave == 0) {
        const int row = row0 + f_lane;
        const float ig = GATES[(size_t)row * 8 + h], fg = GATES[(size_t)row * 8 + 4 + h];
        float bcum = log_sigmoid(fg);
#pragma unroll
        for (int o = 1; o < 64; o <<= 1) { const float t = __shfl_up(bcum, o); if (f_lane >= o) bcum += t; }
        const float u = ig - bcum; float pm = u;
#pragma unroll
        for (int o = 1; o < 64; o <<= 1) { const float t = __shfl_up(pm, o); if (f_lane >= o) pm = fmaxf(pm, t); }
        const float mc = MSC[1024 + unit], M = fmaxf(mc, pm);
        su[f_lane] = u; sM[f_lane] = M; sbt[f_lane] = bcum; sei[f_lane] = __expf(mc - M);
    }
#pragma unroll
    for (int i = 0; i < 4; ++i) { const int idx = f_tid + 512 * i, mat = idx >> 10, row = (idx >> 4) & 63, ch = idx & 15;
        const u32x4 v = *(const u32x4*)((mat ? KC : QC) + (size_t)(row0 + row) * 512 + h * 128 + ch * 8);
        *(LAS u32x4*)((mat ? Ks : Qs) + row * ML_PQ + ch * 8) = v; }
    { const int vp = f_tid & 127, rg = f_tid >> 7;
#pragma unroll 4
        for (int i = 0; i < 16; ++i) { const int s = rg * 16 + i;
            const unsigned x = *(const unsigned*)(PROJ + (size_t)(row0 + s) * NPJ + PC_VM + h * MDV + 2 * vp);
            VT[(2 * vp) * ML_PK + s] = (bf16_t)(x & 0xffffu); VT[(2 * vp + 1) * ML_PK + s] = (bf16_t)(x >> 16); } }
    __syncthreads();
    {
        const float* nst = MSC + 2048 + 65536 + unit * MDQK; const int t = f_tid >> 3, p = f_tid & 7; float s = 0.f;
        const u32x4 qa = *(const LAS u32x4*)(Qs + t * ML_PQ + 16 * p), qb = *(const LAS u32x4*)(Qs + t * ML_PQ + 16 * p + 8);
        const f32x4 n0 = *(const f32x4*)(nst + 16 * p), n1 = *(const f32x4*)(nst + 16 * p + 4), n2 = *(const f32x4*)(nst + 16 * p + 8), n3 = *(const f32x4*)(nst + 16 * p + 12);
        s += bflo(qa.x) * n0[0] + bfhi(qa.x) * n0[1] + bflo(qa.y) * n0[2] + bfhi(qa.y) * n0[3] + bflo(qa.z) * n1[0] + bfhi(qa.z) * n1[1] + bflo(qa.w) * n1[2] + bfhi(qa.w) * n1[3];
        s += bflo(qb.x) * n2[0] + bfhi(qb.x) * n2[1] + bflo(qb.y) * n2[2] + bfhi(qb.y) * n2[3] + bflo(qb.z) * n3[0] + bfhi(qb.z) * n3[1] + bflo(qb.w) * n3[2] + bfhi(qb.w) * n3[3];
        s += __shfl_xor(s, 1); s += __shfl_xor(s, 2); s += __shfl_xor(s, 4);
        if (p == 0) snq[t] = s; }
    int lane_o = f_lane; asm volatile("" : "+v"(lane_o));
    const int r32 = lane_o & 31, hi = lane_o >> 5, w = F.wave;
    f32x16 accI[2], accC[2];
    LAS u32x4* AF = (LAS u32x4*)(lds + 2048 + 2 * 64 * ML_PQ * 2 + 256 * ML_PK * 2);
    LAS float* sdp = su + 384;
    if (w < 3) {
        const int fi = w, tb = fi ? 1 : 0, sb = fi == 2 ? 1 : 0, t = 32 * tb + r32; const float Mt = sM[t];
        f32x16 X = {};
#pragma unroll
        for (int st = 0; st < 8; ++st) { const bf16x8 a = *(const LAS bf16x8*)(Ks + (32 * sb + r32) * ML_PQ + 16 * st + 8 * hi), bq = *(const LAS bf16x8*)(Qs + t * ML_PQ + 16 * st + 8 * hi);
            X = __builtin_amdgcn_mfma_f32_32x32x16_bf16(a, bq, X, 0, 0, 0); }
        float av[16]; float den = 0.f;
#pragma unroll
        for (int i = 0; i < 16; ++i) { const int s = 32 * sb + (i & 3) + 8 * (i >> 2) + 4 * hi;
            const float e = (s <= t) ? __expf(su[s] - Mt) * X[i] : 0.f; av[i] = e; den += e; }
#pragma unroll
        for (int ss = 0; ss < 2; ++ss) { u32x4 p; p.x = pk2(av[8 * ss], av[8 * ss + 1]); p.y = pk2(av[8 * ss + 2], av[8 * ss + 3]); p.z = pk2(av[8 * ss + 4], av[8 * ss + 5]); p.w = pk2(av[8 * ss + 6], av[8 * ss + 7]);
            AF[(fi * 2 + ss) * 64 + lane_o] = p; }
        den += __shfl_xor(den, 32);
        if (hi == 0) sdp[fi * 32 + r32] = den;
    }
    u32x4 ogv[4];
    { const bf16_t* op = PROJ + (size_t)(row0 + (f_tid >> 3)) * NPJ + PC_OM + h * MDV + 32 * (f_tid & 7);
#pragma unroll
      for (int q = 0; q < 4; ++q) ogv[q] = *(const u32x4*)(op + 8 * q); }
    accC[0] = f32x16{}; accC[1] = f32x16{};
#pragma unroll
    for (int st = 0; st < 8; ++st) { const bf16x8 bq = *(const bf16x8*)(CST + (size_t)(32 * w + r32) * MDQK + 16 * st + 8 * hi);
#pragma unroll
        for (int tb = 0; tb < 2; ++tb) { const bf16x8 a = *(const LAS bf16x8*)(Qs + (32 * tb + r32) * ML_PQ + 16 * st + 8 * hi);
            accC[tb] = __builtin_amdgcn_mfma_f32_32x32x16_bf16(a, bq, accC[tb], 0, 0, 0); } }
    __syncthreads();
#pragma unroll
    for (int tb = 0; tb < 2; ++tb) { accI[tb] = f32x16{};
#pragma unroll
        for (int sb = 0; sb <= tb; ++sb)
#pragma unroll
            for (int ss = 0; ss < 2; ++ss) { const LAS bf16_t* vp = VT + (32 * w + r32) * ML_PK + 32 * sb + 16 * ss + 4 * hi;
                const s16x4 lo = *(const LAS s16x4*)vp, hh = *(const LAS s16x4*)(vp + 8);
                const bf16x8 bq = (bf16x8){lo[0], lo[1], lo[2], lo[3], hh[0], hh[1], hh[2], hh[3]};
                const bf16x8 af = __builtin_bit_cast(bf16x8, AF[((tb + sb) * 2 + ss) * 64 + lane_o]);
                accI[tb] = __builtin_amdgcn_mfma_f32_32x32x16_bf16(af, bq, accI[tb], 0, 0, 0); } }
    if (f_tid < MCH) sden[f_tid] = f_tid < 32 ? sdp[f_tid] : sdp[32 + (f_tid - 32)] + sdp[64 + (f_tid - 32)];
    __syncthreads();
    if (f_tid < MCH) {
        const float ei = sei[f_tid], dn = sden[f_tid] + ei * snq[f_tid];
        sden[f_tid] = __builtin_amdgcn_rcpf(fmaxf(fabsf(dn), __expf(-sbt[f_tid] - sM[f_tid]))); }
    __syncthreads();
#pragma unroll
    for (int tb = 0; tb < 2; ++tb)
#pragma unroll
        for (int i = 0; i < 16; ++i) { const int t = 32 * tb + (i & 3) + 8 * (i >> 2) + 4 * hi;
            Hs[t * 257 + 32 * w + r32] = (accI[tb][i] + sei[t] * accC[tb][i]) * sden[t]; }
    __syncthreads();
    {
        const int t = f_tid >> 3, p = f_tid & 7;
        float x[32]; float ss = 0.f;
#pragma unroll
        for (int j = 0; j < 32; ++j) { x[j] = Hs[t * 257 + 32 * p + j]; ss += x[j] * x[j]; }
        ss += __shfl_xor(ss, 1); ss += __shfl_xor(ss, 2); ss += __shfl_xor(ss, 4);
        const float rinv = 1.0f / sqrtf(ss * (1.0f / MDV) + LN_EPS);
        const float* gp = in_m_norm_g + h * MDV + 32 * p;
        bf16_t* dst = CAT + (size_t)(row0 + t) * DM + h * MDV + 32 * p;
#pragma unroll
        for (int q = 0; q < 4; ++q) { const u32x4 ov = ogv[q];
            float og[8]; og[0] = bflo(ov.x); og[1] = bfhi(ov.x); og[2] = bflo(ov.y); og[3] = bfhi(ov.y); og[4] = bflo(ov.z); og[5] = bfhi(ov.z); og[6] = bflo(ov.w); og[7] = bfhi(ov.w);
            const f32x4 ga = *(const f32x4*)(gp + 8 * q), gb = *(const f32x4*)(gp + 8 * q + 4);
            const float gq[8] = {ga[0], ga[1], ga[2], ga[3], gb[0], gb[1], gb[2], gb[3]};
            float r[8];
#pragma unroll
            for (int j = 0; j < 8; ++j) r[j] = x[8 * q + j] * rinv * gq[j] * __builtin_amdgcn_rcpf(1.0f + __expf(-og[j]));
            u32x4 wv; wv.x = pk2(r[0], r[1]); wv.y = pk2(r[2], r[3]); wv.z = pk2(r[4], r[5]); wv.w = pk2(r[6], r[7]);
            *(u32x4*)(dst + 8 * q) = wv; }
    }
    __syncthreads();
}

constexpr int NPHASE = 11;
struct Args { const float* in[21]; float* out; unsigned char* ws; int lo, hi; };
__global__ void __launch_bounds__(512, 2) mega_fwd(Args args) {
    extern __shared__ __attribute__((aligned(16))) unsigned char lds_raw[];
    Frame F;
    F.lds = (LAS unsigned char*)lds_raw;
    F.wave = __builtin_amdgcn_readfirstlane((int)threadIdx.x >> 6);
    F.G = gridDim.x; F.bx = blockIdx.x; F.cgu = 0; F.cdn = 0; F.cgrp = (F.bx >> 3) & 3;
    F.ws = args.ws;
    F.in = args.in; F.outp = &args.out;
    volatile LAS unsigned* MISC = (volatile LAS unsigned*)(F.lds + MISC_OFF);
    if (threadIdx.x < 64) MISC[threadIdx.x] = 0u;
    __syncthreads();
    const int lo = args.lo, hi = args.hi;
    XcdBarrier bar; bar.bar = ((unsigned*)F.ws) + CW_BAR; bar.x = 0; bar.st = nullptr;
    if (hi - lo > 1) bar = xcd_barrier_post(((unsigned*)F.ws) + CW_BAR, MISC + 8);
#ifndef PH_MASK
#define PH_MASK 0x7ff
#endif
#define IN(k) (((PH_MASK >> (k)) & 1) && lo <= (k) && (k) < hi)
#define SEAM(k) do { if (IN(k) && IN((k) + 1)) xcd_barrier(bar); } while (0)

#ifndef CVQ_GU
#define CVQ_GU 16
#endif
#ifndef DBG_DOUBLE
#define DBG_DOUBLE 0
#endif
#define PHASE(k, ...) do { if (IN(k)) { __VA_ARGS__ if constexpr ((DBG_DOUBLE >> (k)) & 1) { xcd_barrier(bar); __VA_ARGS__ } } SEAM(k); } while (0)
    PHASE(0, { p0_prologue(F); });
    PHASE(1, { p1_modulate(F); });
    PHASE(2, {
        if (F.cgrp == 0) conv_gu(F, CVQ_GU);
        PbProj P; P.Fp = &F; P.hook_unit = F.cgrp - 1; P.hook_n = (F.cgrp == 1 || F.cgrp == 2) ? CVQ_GU : 0; P.Abase = (const char*)WSP(bf16_t, WS_H); P.Bt = (const char*)WSP(bf16_t, WS_WIN_T); P.S.init(NTOK, NPJ, F.G, F.bx); P.O = WSP(bf16_t, WS_PROJ); P.bias = WSP(const float, WS_BIN2);
        pg8::gemm_phase<PbProj>(F.lds, P);
        if (F.cgrp == 3) conv_gu(F, CVQ_GU); });
    PHASE(3, {
        if (F.cgrp == 0) conv_gu(F, 16);
        p3_attention(F);
        if (F.cgrp == 2) conv_gu(F, 16);
        for (int u = F.bx; u < 16 * NCH; u += F.G) mlstm_a_unit(F, u);
        if (F.cgrp == 3) conv_gu(F, 16); });
    PHASE(4, { mlstm_b_scan(F); });
    PHASE(5, { for (int u = F.bx; u < 16 * NCH; u += F.G) mlstm_c_unit(F, u); });
    PHASE(6, {
        PbOut P; P.Abase = (const char*)WSP(bf16_t, WS_CAT); P.Bt = (const char*)WSP(bf16_t, WS_WOUT_T); P.S.init(NTOK, DM, F.G, F.bx); P.C = WSP(bf16_t, WS_Y1);
        pg8::gemm_phase<PbOut>(F.lds, P); });
    PHASE(7, { p7_ln1_router(F); conv_gu(F, 64); });
    PHASE(8, {
        if (F.cgrp == 0) conv_dn(F, 64);
        PbGu P; P.Fp = &F; P.hook_unit = 2 * F.cgrp - 1; P.hook_n = F.cgrp ? 64 : 0; P.T.lds = F.lds; P.T.nun = moe_setup(F, 16);
        P.Abase = (const char*)WSP(unsigned char, WS_H2Q); P.Wt = (const char*)WSP(unsigned char, WS_WGU_T); P.bias = WSP(const float, WS_BGU2); P.ACT = WSP(unsigned char, WS_ACT);
        pg8::gemm_phase<PbGu>(F.lds, P);
        conv_dn(F, 64); });
    PHASE(9, {
        PbDn P; P.T.lds = F.lds; P.T.nun = moe_setup(F, 8);
        P.Abase = (const char*)WSP(unsigned char, WS_ACT); P.Wt = (const char*)WSP(unsigned char, WS_WDN_T); P.bias = FIN(I_BDN); P.YP = WSP(unsigned char, WS_YP);
        pg8::gemm_phase<PbDn>(F.lds, P); });
    PHASE(10, { p10_ln2(F); });
#undef PHASE
#undef IN
#undef SEAM
}

extern "C" void kernel_launch(void* const* d_in, const int* in_sizes, int n_in, void* d_out, int out_size, void* d_ws, size_t ws_size, hipStream_t stream) {
    static int grid = 0;
    if (!grid) {
        int dev = 0, cus = 0, per_cu = 0;
        if (n_in != 21 || ws_size < WS_END) { fprintf(stderr, "kernel_launch: unexpected n_in %d or ws_size %zu\n", n_in, ws_size); return; }
        (void)hipGetDevice(&dev);
        (void)hipDeviceGetAttribute(&cus, hipDeviceAttributeMultiprocessorCount, dev);
        if (hipFuncSetAttribute((const void*)mega_fwd, hipFuncAttributeMaxDynamicSharedMemorySize, LDS_BYTES) != hipSuccess) { fprintf(stderr, "kernel_launch: hipFuncSetAttribute failed\n"); return; }
        if (hipOccupancyMaxActiveBlocksPerMultiprocessor(&per_cu, (const void*)mega_fwd, 512, LDS_BYTES) != hipSuccess || per_cu < 1) { fprintf(stderr, "kernel_launch: occupancy query says %d\n", per_cu); per_cu = 1; }
        grid = cus;
    }
    (void)hipMemsetAsync((char*)d_ws + WS_CTL, 0, CTL_ZERO_BYTES, stream);
    Args a{};
    for (int i = 0; i < 21; ++i) a.in[i] = (const float*)d_in[i];
    a.out = (float*)d_out; a.ws = (unsigned char*)d_ws;
#if N_LAUNCH_MODE == 1
    a.lo = 0; a.hi = NPHASE;
    hipLaunchKernelGGL(mega_fwd, dim3(grid), dim3(512), LDS_BYTES, stream, a);
#else
    for (int k = 0; k < NPHASE; ++k) { a.lo = k; a.hi = k + 1; hipLaunchKernelGGL(mega_fwd, dim3(grid), dim3(512), LDS_BYTES, stream, a); }
#endif
    hipError_t le = hipGetLastError();
    if (le != hipSuccess) fprintf(stderr, "kernel_launch: launch failed: %s\n", hipGetErrorName(le));
}
```

```cpp
#include <hip/hip_runtime.h>
#include <cstdio>
#include <cstdint>

#ifndef N_LAUNCH_MODE
#define N_LAUNCH_MODE 1
#endif

#define LAS __attribute__((address_space(3)))
#define GAS __attribute__((address_space(1)))
typedef unsigned short bf16_t;
typedef short bf16x8 __attribute__((ext_vector_type(8)));
typedef short s16x4 __attribute__((ext_vector_type(4)));
typedef float f32x2 __attribute__((ext_vector_type(2)));
typedef float f32x4 __attribute__((ext_vector_type(4)));
typedef float f32x16 __attribute__((ext_vector_type(16)));
typedef unsigned u32x2 __attribute__((ext_vector_type(2)));
typedef unsigned u32x4 __attribute__((ext_vector_type(4)));
typedef int i32x4 __attribute__((ext_vector_type(4)));
typedef int i32x2 __attribute__((ext_vector_type(2)));
typedef int i32x8 __attribute__((ext_vector_type(8)));
constexpr float YP_SCALE = 16.0f, YP_INV = 1.0f / 16.0f;
constexpr float WQ_SCALE = 64.0f, WQ_INV = 1.0f / 64.0f;

constexpr int NB = 4, SEQ = 2048, DM = 2048, NTOK = NB * SEQ;
constexpr int NPJ = 6144;
constexpr int PJ_SRC = 6152;
constexpr int NE = 32, TOPK = 4, DFF = 2048;
constexpr int MH = 4, MDV = 256, MDQK = 128, MCH = 64, NCH = SEQ / MCH;
constexpr int AH = 16, ADH = 64;
constexpr float LN_EPS = 1e-5f;
constexpr float DN_ALPHA = 1.189207115002721f;
constexpr float SW_ALPHA = 1.702f, SW_LIMIT = 7.0f;
constexpr float LOG2E = 1.4426950408889634f;
constexpr float ATT_C2 = 0.125f * LOG2E;
constexpr int PC_QM = 0, PC_KM = 512, PC_VM = 1024, PC_OM = 2048, PC_QA = 3072, PC_KA = 4096, PC_VA = 5120;
constexpr int MOD_W = 6 * DM;

constexpr size_t MiB = 1u << 20;
constexpr size_t WS_CTL = 0, CTL_ZERO_BYTES = 131072;
constexpr size_t WS_BIN2 = 2 * MiB;
constexpr size_t WS_BGU2 = 2 * MiB + 65536;
constexpr size_t WS_RWT = 3 * MiB - 262144;
constexpr size_t WS_LIST = 3 * MiB;
constexpr size_t WS_GATE = 4 * MiB;
constexpr size_t WS_GATES = 5 * MiB;
constexpr size_t WS_MSC = 6 * MiB;
constexpr size_t WS_WIN_T = 8 * MiB;
constexpr size_t WS_WOUT_T = 32 * MiB;
constexpr size_t WS_H = 40 * MiB;
constexpr size_t WS_CAT = 72 * MiB;
constexpr size_t WS_PROJ = 104 * MiB;
constexpr size_t WS_QC = 200 * MiB, WS_KC = 208 * MiB;
constexpr size_t WS_U = 216 * MiB;
constexpr size_t WS_CST = 280 * MiB;
constexpr size_t WS_Y1 = 312 * MiB;
constexpr size_t WS_X1 = 376 * MiB;
constexpr size_t WS_ACT = 440 * MiB;
constexpr size_t WS_H2Q = 560 * MiB;
constexpr size_t WS_YP = 600 * MiB;
constexpr size_t WS_WGU_T = 728 * MiB;
constexpr size_t WS_WDN_T = 1240 * MiB;
constexpr size_t WS_END = 1496 * MiB;
constexpr int CW_BAR = 4096;
constexpr int CW_CNT = 16384;
constexpr int CW_MOD = 65536;
static_assert((CW_CNT + 64 * NE) * 4 <= (int)CTL_ZERO_BYTES && (CW_MOD + NB * MOD_W) * 4 <= (int)(2 * MiB), "ctl");

constexpr int RING_BYTES = 131072;
constexpr int RT_OFF = RING_BYTES, RT_SLOTS = 12, RT_BYTES = RT_SLOTS * 2048;
constexpr int UD_OFF = RT_OFF + RT_BYTES;
constexpr int MISC_OFF = UD_OFF + 1024;
constexpr int BIAS_OFF = MISC_OFF + 256;
constexpr int LDS_BYTES = BIAS_OFF + 2048;
static_assert(LDS_BYTES <= 163840, "LDS");

__device__ __forceinline__ unsigned f2bf(float f) { unsigned u = __builtin_bit_cast(unsigned, f); return (u + 0x7fffu + ((u >> 16) & 1u)) >> 16; }
__device__ __forceinline__ unsigned pk2(float lo, float hi) { return f2bf(lo) | (f2bf(hi) << 16); }
__device__ __forceinline__ unsigned pk4_fp8(float a, float b, float c, float d) { unsigned w = 0u; w = (unsigned)__builtin_amdgcn_cvt_pk_fp8_f32(a, b, (int)w, false); w = (unsigned)__builtin_amdgcn_cvt_pk_fp8_f32(c, d, (int)w, true); return w; }
__device__ __forceinline__ float bf2f(unsigned short b) { return __builtin_bit_cast(float, ((unsigned)b) << 16); }
__device__ __forceinline__ float bflo(unsigned w) { return __builtin_bit_cast(float, w << 16); }
__device__ __forceinline__ float bfhi(unsigned w) { return __builtin_bit_cast(float, w & 0xffff0000u); }
template <int CTRL> __device__ __forceinline__ float dpp_mov(float v) { return __builtin_bit_cast(float, __builtin_amdgcn_update_dpp(0, __builtin_bit_cast(int, v), CTRL, 0xF, 0xF, true)); }
__device__ __forceinline__ float sum8(float v) { v += dpp_mov<0xB1>(v); v += dpp_mov<0x4E>(v); v += dpp_mov<0x141>(v); return v; }
template <int CTRL, int RMASK> __device__ __forceinline__ float dpp_id(float v, float ident) { return __builtin_bit_cast(float, __builtin_amdgcn_update_dpp(__builtin_bit_cast(int, ident), __builtin_bit_cast(int, v), CTRL, RMASK, 0xF, false)); }
__device__ __forceinline__ float wave_scan_sum(float v) {
    v += dpp_id<0x111, 0xF>(v, 0.f); v += dpp_id<0x112, 0xF>(v, 0.f); v += dpp_id<0x114, 0xF>(v, 0.f); v += dpp_id<0x118, 0xF>(v, 0.f);
    v += dpp_id<0x142, 0xA>(v, 0.f); v += dpp_id<0x143, 0xC>(v, 0.f); return v;
}
__device__ __forceinline__ float wave_scan_max(float v) {
    v = fmaxf(v, dpp_id<0x111, 0xF>(v, -INFINITY)); v = fmaxf(v, dpp_id<0x112, 0xF>(v, -INFINITY)); v = fmaxf(v, dpp_id<0x114, 0xF>(v, -INFINITY)); v = fmaxf(v, dpp_id<0x118, 0xF>(v, -INFINITY));
    v = fmaxf(v, dpp_id<0x142, 0xA>(v, -INFINITY)); v = fmaxf(v, dpp_id<0x143, 0xC>(v, -INFINITY)); return v;
}
__device__ __forceinline__ float wave_sum(float v) {
    v = sum8(v); v += dpp_mov<0x140>(v);
    { unsigned a = __builtin_bit_cast(unsigned, v), b = a; asm volatile("" : "+v"(b)); const auto r = __builtin_amdgcn_permlane16_swap(a, b, false, false); v = __uint_as_float(r[0]) + __uint_as_float(r[1]); }
    { unsigned a = __builtin_bit_cast(unsigned, v), b = a; asm volatile("" : "+v"(b)); const auto r = __builtin_amdgcn_permlane32_swap(a, b, false, false); v = __uint_as_float(r[0]) + __uint_as_float(r[1]); }
    return v;
}
__device__ __forceinline__ float wave_max(float v) {
    v = fmaxf(v, dpp_mov<0xB1>(v)); v = fmaxf(v, dpp_mov<0x4E>(v)); v = fmaxf(v, dpp_mov<0x141>(v)); v = fmaxf(v, dpp_mov<0x140>(v));
    { unsigned a = __builtin_bit_cast(unsigned, v), b = a; asm volatile("" : "+v"(b)); const auto r = __builtin_amdgcn_permlane16_swap(a, b, false, false); v = fmaxf(__uint_as_float(r[0]), __uint_as_float(r[1])); }
    { unsigned a = __builtin_bit_cast(unsigned, v), b = a; asm volatile("" : "+v"(b)); const auto r = __builtin_amdgcn_permlane32_swap(a, b, false, false); v = fmaxf(__uint_as_float(r[0]), __uint_as_float(r[1])); }
    return v;
}
#define LDS_WAIT() asm volatile("s_waitcnt lgkmcnt(0)" ::: "memory")
#define VM_WAIT() asm volatile("s_waitcnt vmcnt(0)" ::: "memory")

#define XB_TMO      128
#define XB_XCNT(j)  (256  + 64 * (j))
#define XB_XSUB(j)  (1280 + 64 * (j))
#define XB_XGEN(j)  (2304 + 64 * (j))
#define XB_TOP      3328
#define XB_TOPGEN   3392
#define XCD_BAR_WORDS 3456
#define XB_SPIN_CAP (1u << 18)
__device__ __forceinline__ unsigned xb_ld(unsigned* p)              { return __hip_atomic_load(p, __ATOMIC_RELAXED, __HIP_MEMORY_SCOPE_AGENT); }
__device__ __forceinline__ unsigned xb_add(unsigned* p, unsigned v) { return __hip_atomic_fetch_add(p, v, __ATOMIC_RELAXED, __HIP_MEMORY_SCOPE_AGENT); }
__device__ __forceinline__ unsigned xb_xcc_id() { return (unsigned)__builtin_amdgcn_s_getreg((3 << 11) | 20) & 0xFu; }
#define XB_SPIN(cond, bar) do { unsigned _sp = 0; while (cond) { __builtin_amdgcn_s_sleep(1); \
    if ((++_sp & 255u) == 0u) { if (xb_ld(&(bar)[XB_TMO])) break; if (_sp > XB_SPIN_CAP) { atomicAdd(&(bar)[XB_TMO], 1u); break; } } } } while (0)
struct XcdBarrier { unsigned* bar; unsigned x; volatile LAS unsigned* st; };
__device__ __forceinline__ XcdBarrier xcd_barrier_post(unsigned* bar, volatile LAS unsigned* st) {
    XcdBarrier b; b.bar = bar; b.x = xb_xcc_id(); b.st = st;
    if (threadIdx.x == 0) (void)xb_add(&bar[XB_XCNT(b.x)], 1u);
    return b;
}
__device__ __forceinline__ void xcd_barrier_complete(unsigned* bar, unsigned x, unsigned& nloc, unsigned& nx) {
    const unsigned G = gridDim.x * gridDim.y * gridDim.z;
    unsigned sum, cnt, mine, sp = 0u;
    for (;;) {
        sum = 0u; cnt = 0u; mine = 0u;
#pragma unroll
        for (unsigned j = 0; j < 16; ++j) { const unsigned c = xb_ld(&bar[XB_XCNT(j)]); sum += c; cnt += (c > 0u) ? 1u : 0u; mine = (j == x) ? c : mine; }
        if (sum == G) break;
        __builtin_amdgcn_s_sleep(1);
        if ((++sp & 255u) == 0u) { if (xb_ld(&bar[XB_TMO])) break; if (sp > XB_SPIN_CAP) { atomicAdd(&bar[XB_TMO], 1u); break; } }
    }
    nloc = mine > 0u ? mine : 1u; nx = cnt > 0u ? cnt : 1u;
}
__device__ __forceinline__ void xcd_barrier(const XcdBarrier& b) {
    asm volatile("s_waitcnt vmcnt(0)" ::: "memory");
    __syncthreads();
    if (threadIdx.x == 0) {
        unsigned* bar = b.bar;
        __builtin_amdgcn_s_waitcnt(0);
        unsigned nloc = b.st[0], nx = b.st[1];
        if (nloc == 0u) { xcd_barrier_complete(bar, b.x, nloc, nx); b.st[0] = nloc; b.st[1] = nx; }
        const unsigned old = xb_add(&bar[XB_XSUB(b.x)], 1u);
        const unsigned gen = old / nloc;
        if (old + 1u == (gen + 1u) * nloc) {
            __builtin_amdgcn_fence(__ATOMIC_RELEASE, "agent");
            asm volatile("s_waitcnt vmcnt(0)" ::: "memory");
            const unsigned og = xb_add(&bar[XB_TOP], 1u);
            const unsigned tg = og / nx;
            if (og + 1u == (tg + 1u) * nx) xb_add(&bar[XB_TOPGEN], 1u);
            else XB_SPIN(xb_ld(&bar[XB_TOPGEN]) == tg, bar);
            __builtin_amdgcn_fence(__ATOMIC_ACQUIRE, "agent");
            xb_add(&bar[XB_XGEN(b.x)], 1u);
            asm volatile("s_waitcnt vmcnt(0)" ::: "memory");
        } else {
            XB_SPIN(xb_ld(&bar[XB_XGEN(b.x)]) == gen, bar);
            __builtin_amdgcn_fence(__ATOMIC_ACQUIRE, "agent");
            asm volatile("s_waitcnt vmcnt(0)" ::: "memory");
        }
    }
    __syncthreads();
}

struct Frame {
    LAS unsigned char* lds;
    int wave, G, bx;
    int cgu, cdn, cgrp;
    unsigned char* ws;
    const float* const* in;
    float* const* outp;
};
__device__ __forceinline__ int tid_id() { int t = threadIdx.x; asm volatile("" : "+v"(t)); return t; }
__device__ __forceinline__ int lane_id() { return tid_id() & 63; }
__device__ __forceinline__ int opq(int k) { asm volatile("" : "+s"(k)); return k; }
#define FIN(k) (F.in[opq(k)])
__device__ __forceinline__ void conv_gu(Frame& F, int n);
__device__ __forceinline__ void conv_dn(Frame& F, int n);
enum { I_X = 0, I_C, I_WADA, I_BADA, I_WIN, I_BIN, I_CONVW, I_CONVB, I_MNG, I_ANG, I_WOUT, I_LN1G, I_LN1B, I_RW, I_RB, I_WGU, I_BGU, I_WDN, I_BDN, I_LN2G, I_LN2B };
#define WSP(T, off) ((T*)(F.ws + (off)))

namespace pg8 {
constexpr int BM = 256, BK = 64, HALF = 128, HTB = HALF * BK * 2, STAGE_BYTES = 8 * HTB, NXCD = 8, WGM = 8, KD = 2048;
__host__ __device__ __forceinline__ int lds_byte(int r, int c) { const int st = (r >> 4) * 2 + (c >> 5), rr = r & 15, cc = c & 31, ob = rr * 64 + cc * 2; return st * 1024 + (ob ^ (((ob >> 9) & 1) << 5)); }
__host__ __device__ __forceinline__ void stage_rc(int b, int& R, int& C) { const int st = b / 1024, sb = b % 1024, swz = sb ^ (((sb >> 9) & 1) << 5); R = (st >> 1) * 16 + swz / 64; C = (st & 1) * 32 + (swz % 64) / 2; }
__host__ __device__ __forceinline__ int perm32(int rho) { const int n = rho >> 4, i = rho & 15; return 8 * (i >> 2) + 4 * n + (i & 3); }
struct Unit { int pm, pn, e, slot, half, nh; };
typedef f32x4 Acc[2][2][4][2];

struct StaticOrder {
    int nM, nN, nwg, G, c;
    __device__ void init(int M, int N, int G_, int c_) { nM = M / BM; nN = N / BM; nwg = nM * nN; G = G_; c = c_; }
    __device__ bool next(int i, Unit& u) const {
        const long L = (long)i * G + c; if (L >= nwg) return false;
        int wgid = (int)L; { const int q = nwg / NXCD, r = nwg % NXCD, xcd = wgid % NXCD, off = wgid / NXCD; wgid = (xcd < r ? xcd * (q + 1) : r * (q + 1) + (xcd - r) * q) + off; }
        const int nig = WGM * nN, gid = wgid / nig, fm = gid * WGM, gsz = (nM - fm) < WGM ? (nM - fm) : WGM;
        u.pm = fm + ((wgid % nig) % gsz); u.pn = (wgid % nig) / gsz; u.e = 0; u.slot = 0; u.half = 0; u.nh = 0; return true;
    }
};

template <class PB>
__device__ __forceinline__ void gemm_phase(LAS unsigned char* lds, const PB& P) {
    const int tid = threadIdx.x, wid = __builtin_amdgcn_readfirstlane(tid >> 6), lane = tid & 63, wr = wid >> 2, wc = wid & 3, fr = lane & 15, fq = lane >> 4;
    constexpr int K = KD, PITCH = PB::FP8 ? K : 2 * K, nt = PB::FP8 ? K / 128 : K / BK;
    int Rr[2], Cb[2]; unsigned voffB[2];
#pragma unroll
    for (int i = 0; i < 2; ++i) { int R, C; stage_rc(tid * 16 + i * 8192, R, C); const int Rb = PB::COL16 ? ((R >> 5) * 64 + 16 * ((R & 15) >> 2) + 4 * ((R >> 4) & 1) + (R & 3)) : PB::SWAP16 ? ((R & ~31) + 16 * (((R & 15) >> 2) & 1) + 8 * ((R & 15) >> 3) + 4 * ((R >> 4) & 1) + (R & 3)) : (PB::PERM ? ((R & ~31) + perm32(R & 31)) : R);
        Rr[i] = R; Cb[i] = C * 2; voffB[i] = (unsigned)(Rb * PITCH + C * 2); }
    constexpr size_t kstep = (size_t)(BK * 2);
    constexpr size_t hstep = (size_t)(PB::COL16 ? 8 : HALF) * PITCH;
    const unsigned ldsw = (unsigned)wid * 1024u;
    const int aoff = lds_byte(wr * 64 + fr, fq * 8), boff = lds_byte(wc * 32 + fr, fq * 8);
#define PG8_SA(b, h) (((b) * 2 + (h)) * HTB)
#define PG8_SB(b, h) ((4 + (b) * 2 + (h)) * HTB)
#define PG8_STAGE(bufoff, gbase, voff) do { _Pragma("unroll") for (int _i = 0; _i < 2; ++_i) \
        __builtin_amdgcn_global_load_lds((const unsigned*)((const char*)(gbase) + (voff)[_i]), (LAS unsigned*)(lds + (bufoff) + ldsw + _i * 8192), 16, 0, 0); } while (0)
#define PG8_LD16(off) (*(const LAS i32x4*)(lds + (off)))
#define PG8_LDA(dst, b, h) do { _Pragma("unroll") for (int m = 0; m < 4; ++m) dst[m] = __builtin_shufflevector(PG8_LD16(PG8_SA(b, h) + aoff + m * 2048), PG8_LD16(PG8_SA(b, h) + aoff + m * 2048 + 1024), 0, 1, 2, 3, 4, 5, 6, 7); } while (0)
#define PG8_LDB(dst, b, h) do { _Pragma("unroll") for (int n = 0; n < 2; ++n) dst[n] = __builtin_shufflevector(PG8_LD16(PG8_SB(b, h) + boff + n * 2048), PG8_LD16(PG8_SB(b, h) + boff + n * 2048 + 1024), 0, 1, 2, 3, 4, 5, 6, 7); } while (0)
#define PG8_LO(x) __builtin_bit_cast(bf16x8, __builtin_shufflevector((x), (x), 0, 1, 2, 3))
#define PG8_HI(x) __builtin_bit_cast(bf16x8, __builtin_shufflevector((x), (x), 4, 5, 6, 7))
#define PG8_MMA(ai, bj, At, Bt) do { __builtin_amdgcn_s_setprio(1); _Pragma("unroll") for (int m = 0; m < 4; ++m) _Pragma("unroll") for (int n = 0; n < 2; ++n) { \
        if constexpr (PB::FP8) asm volatile("v_mfma_scale_f32_16x16x128_f8f6f4 %0, %1, %2, %0, %3, %3 op_sel_hi:[0,0,0]" : "+v"(acc[ai][bj][m][n]) : "v"(Bt[n]), "v"(At[m]), "v"(fp8_one)); \
        else { acc[ai][bj][m][n] = __builtin_amdgcn_mfma_f32_16x16x32_bf16(PG8_LO(Bt[n]), PG8_LO(At[m]), acc[ai][bj][m][n], 0, 0, 0); \
               acc[ai][bj][m][n] = __builtin_amdgcn_mfma_f32_16x16x32_bf16(PG8_HI(Bt[n]), PG8_HI(At[m]), acc[ai][bj][m][n], 0, 0, 0); } } \
        __builtin_amdgcn_s_setprio(0); } while (0)
#define PG8_WAIT_V(n) asm volatile("s_waitcnt vmcnt(" #n ")" ::: "memory")
#define PG8_WAIT_L(n) asm volatile("s_waitcnt lgkmcnt(" #n ")" ::: "memory")
#define PG8_BAR __builtin_amdgcn_s_barrier()
#define PG8_SCHED __builtin_amdgcn_sched_barrier(0)
#define PG8_AOFFS(dst, u) do { _Pragma("unroll") for (int h_ = 0; h_ < 2; ++h_) _Pragma("unroll") for (int i_ = 0; i_ < 2; ++i_) dst[h_][i_] = P.a_off(u, h_ * HALF + Rr[i_]) + (unsigned)Cb[i_]; } while (0)
    Unit cur, nxt; int ui = 0;
    if (!P.next(0, cur)) return;
    Acc acc;
#pragma unroll
    for (int a = 0; a < 2; ++a)
#pragma unroll
        for (int b = 0; b < 2; ++b)
#pragma unroll
            for (int m = 0; m < 4; ++m)
#pragma unroll
                for (int n = 0; n < 2; ++n) acc[a][b][m][n] = (f32x4){0.f, 0.f, 0.f, 0.f};
    const unsigned fp8_one = 0x7F7F7F7Fu;
    i32x8 At[4], B0[2], B1[2];
    unsigned vA[2][2], vN[2][2];
    PG8_AOFFS(vA, cur);
    const char* Ab = P.Abase;
    const char* cB = P.b_ptr(cur);
    size_t hsC = P.nfull(cur) ? hstep : 0, hsN = hstep;
    PG8_STAGE(PG8_SB(0, 0), cB, voffB); PG8_STAGE(PG8_SB(0, 1), cB + hsC, voffB); PG8_STAGE(PG8_SA(0, 0), Ab, vA[0]); PG8_STAGE(PG8_SA(0, 1), Ab, vA[1]);
    if (wr == 1) PG8_BAR;
    PG8_WAIT_V(2); PG8_BAR;
    PG8_STAGE(PG8_SB(1, 0), cB + kstep, voffB); PG8_STAGE(PG8_SA(1, 0), Ab + kstep, vA[0]); PG8_STAGE(PG8_SB(1, 1), cB + hsC + kstep, voffB);
    PG8_WAIT_V(6); PG8_BAR;
    for (;;) {
        const bool has_next = P.next(ui + 1, nxt);
        const char* nB = cB;
        if (has_next) { PG8_AOFFS(vN, nxt); nB = P.b_ptr(nxt); hsN = P.nfull(nxt) ? hstep : 0; }
        else {
#pragma unroll
            for (int h_ = 0; h_ < 2; ++h_)
#pragma unroll
                for (int i_ = 0; i_ < 2; ++i_) vN[h_][i_] = vA[h_][i_]; }
        const bool full = P.full(cur), nfull = P.nfull(cur);
        if constexpr (PB::BIAS) { if (wid == 0) __builtin_amdgcn_global_load_lds((const unsigned*)(P.bias_src(cur) + lane * 4), (LAS unsigned*)(lds + BIAS_OFF + (ui & 1) * 1024), 16, 0, 0); }
        for (int t = 0; t < nt; t += 2) {
            const bool last = (t == nt - 2);
            const char* a1 = Ab + (size_t)(t + 1) * kstep;
            const char* a2 = last ? Ab : Ab + (size_t)(t + 2) * kstep; const char* b2 = last ? nB : cB + (size_t)(t + 2) * kstep;
            const char* a3 = a2 + kstep; const char* b3 = b2 + kstep; const size_t hs2 = last ? hsN : hsC;
            unsigned w2[2][2];
#pragma unroll
            for (int h_ = 0; h_ < 2; ++h_)
#pragma unroll
                for (int i_ = 0; i_ < 2; ++i_) w2[h_][i_] = last ? vN[h_][i_] : vA[h_][i_];
            PG8_LDB(B0, 0, 0); if (nfull) PG8_LDB(B1, 0, 1); PG8_SCHED; PG8_LDA(At, 0, 0); PG8_STAGE(PG8_SA(1, 1), a1, vA[1]);
            PG8_WAIT_V(8); PG8_WAIT_L(0); PG8_BAR; PG8_MMA(0, 0, At, B0); if (nfull) PG8_MMA(0, 1, At, B1); PG8_BAR; PG8_SCHED;
            if (full) PG8_LDA(At, 0, 1); PG8_STAGE(PG8_SB(0, 0), b2, voffB); PG8_STAGE(PG8_SB(0, 1), b2 + hs2, voffB); PG8_STAGE(PG8_SA(0, 0), a2, w2[0]);
            PG8_WAIT_V(8); PG8_WAIT_L(0); PG8_BAR; if (full) { PG8_MMA(1, 0, At, B0); if (nfull) PG8_MMA(1, 1, At, B1); } PG8_BAR; PG8_SCHED;
            PG8_LDB(B0, 1, 0); if (nfull) PG8_LDB(B1, 1, 1); PG8_SCHED; PG8_LDA(At, 1, 0); PG8_STAGE(PG8_SA(0, 1), a2, w2[1]);
            PG8_WAIT_V(8); PG8_WAIT_L(0); PG8_BAR; PG8_MMA(0, 0, At, B0); if (nfull) PG8_MMA(0, 1, At, B1); PG8_BAR; PG8_SCHED;
            if (full) PG8_LDA(At, 1, 1); PG8_STAGE(PG8_SB(1, 0), b3, voffB); PG8_STAGE(PG8_SB(1, 1), b3 + hs2, voffB); PG8_STAGE(PG8_SA(1, 0), a3, w2[0]);
            PG8_WAIT_V(8); PG8_WAIT_L(0); PG8_BAR; if (full) { PG8_MMA(1, 0, At, B0); if (nfull) PG8_MMA(1, 1, At, B1); } PG8_BAR; PG8_SCHED;
        }
        if (wr == 0) PG8_BAR;
        if constexpr (PB::FP8) asm volatile("s_nop 15\n\ts_nop 15" ::: "memory");
        P.epi(acc, cur, wr, wc, fr, fq, (const LAS float*)(lds + BIAS_OFF + (ui & 1) * 1024));
        P.hook(ui);
        if (!has_next) break;
#pragma unroll
        for (int a = 0; a < 2; ++a)
#pragma unroll
            for (int b = 0; b < 2; ++b)
#pragma unroll
                for (int m = 0; m < 4; ++m)
#pragma unroll
                    for (int n = 0; n < 2; ++n) acc[a][b][m][n] = (f32x4){0.f, 0.f, 0.f, 0.f};
        cur = nxt; cB = nB; hsC = hsN; ++ui;
#pragma unroll
        for (int h_ = 0; h_ < 2; ++h_)
#pragma unroll
            for (int i_ = 0; i_ < 2; ++i_) vA[h_][i_] = vN[h_][i_];
        if (wr == 1) PG8_BAR;
    }
    PG8_WAIT_V(0);
    PG8_BAR;
#undef PG8_SA
#undef PG8_SB
#undef PG8_STAGE
#undef PG8_LDA
#undef PG8_LDB
#undef PG8_MMA
#undef PG8_LD16
#undef PG8_LO
#undef PG8_HI
#undef PG8_WAIT_V
#undef PG8_WAIT_L
#undef PG8_BAR
#undef PG8_SCHED
#undef PG8_AOFFS
}
__device__ __forceinline__ unsigned cvt_pk_bf16(float lo, float hi) { unsigned r; asm volatile("v_cvt_pk_bf16_f32 %0, %1, %2" : "=v"(r) : "v"(lo), "v"(hi)); return r; }
}

struct PbProj {
    static constexpr bool PERM = true, FP8 = false, COL16 = false, SWAP16 = false;
    const char* Abase; const char* Bt; pg8::StaticOrder S; bf16_t* O; const float* bias; Frame* Fp; int hook_unit, hook_n;
    __device__ __forceinline__ void hook(int ui) const { if (ui == hook_unit) conv_gu(*Fp, hook_n); }
    __device__ __forceinline__ bool next(int i, pg8::Unit& u) const { return S.next(i, u); }
    __device__ __forceinline__ bool full(const pg8::Unit&) const { return true; }
    __device__ __forceinline__ bool nfull(const pg8::Unit&) const { return true; }
    __device__ __forceinline__ unsigned a_off(const pg8::Unit& u, int row) const { return (unsigned)((u.pm * 256 + row) * 2048) * 2u; }
    __device__ __forceinline__ const char* b_ptr(const pg8::Unit& u) const { return Bt + (size_t)u.pn * 256 * 2048 * 2; }
    static constexpr bool BIAS = true;
    __device__ __forceinline__ const float* bias_src(const pg8::Unit& u) const { return bias + u.pn * 256; }
    __device__ __forceinline__ void epi(const pg8::Acc& acc, const pg8::Unit& u, int wr, int wc, int fr, int fq, const LAS float* lb) const {
        const int row0 = u.pm * 256 + wr * 64 + fr, col0 = u.pn * 256 + wc * 32 + 8 * fq;
        const float sc = (u.pn >= PC_QA / 256 && u.pn < PC_KA / 256) ? ATT_C2 : 1.0f;
        f32x4 bv[2][2];
#pragma unroll
        for (int bj = 0; bj < 2; ++bj)
#pragma unroll
            for (int n = 0; n < 2; ++n) bv[bj][n] = *(const LAS f32x4*)(lb + wc * 32 + 8 * fq + bj * 128 + 4 * n);
#pragma unroll
        for (int ai = 0; ai < 2; ++ai)
#pragma unroll
            for (int m = 0; m < 4; ++m) { bf16_t* rowp = O + (size_t)(row0 + ai * 128 + m * 16) * NPJ + col0;
#pragma unroll
                for (int bj = 0; bj < 2; ++bj) { const f32x4 v0 = (acc[ai][bj][m][0] + bv[bj][0]) * sc, v1 = (acc[ai][bj][m][1] + bv[bj][1]) * sc;
                    u32x4 w; w.x = pg8::cvt_pk_bf16(v0[0], v0[1]); w.y = pg8::cvt_pk_bf16(v0[2], v0[3]); w.z = pg8::cvt_pk_bf16(v1[0], v1[1]); w.w = pg8::cvt_pk_bf16(v1[2], v1[3]);
                    *(u32x4*)(rowp + bj * 128) = w; } }
    }
};
struct PbOut {
    static constexpr bool PERM = true, FP8 = false, COL16 = false, SWAP16 = false;
    const char* Abase; const char* Bt; pg8::StaticOrder S; bf16_t* C;
    __device__ __forceinline__ void hook(int) const {}
    __device__ __forceinline__ bool next(int i, pg8::Unit& u) const { return S.next(i, u); }
    __device__ __forceinline__ bool full(const pg8::Unit&) const { return true; }
    __device__ __forceinline__ bool nfull(const pg8::Unit&) const { return true; }
    __device__ __forceinline__ unsigned a_off(const pg8::Unit& u, int row) const { return (unsigned)((u.pm * 256 + row) * 2048) * 2u; }
    __device__ __forceinline__ const char* b_ptr(const pg8::Unit& u) const { return Bt + (size_t)u.pn * 256 * 2048 * 2; }
    static constexpr bool BIAS = false;
    __device__ __forceinline__ const float* bias_src(const pg8::Unit&) const { return nullptr; }
    __device__ __forceinline__ void epi(const pg8::Acc& acc, const pg8::Unit& u, int wr, int wc, int fr, int fq, const LAS float*) const {
        const int row0 = u.pm * 256 + wr * 64 + fr, col0 = u.pn * 256 + wc * 32 + 8 * fq;
#pragma unroll
        for (int ai = 0; ai < 2; ++ai)
#pragma unroll
            for (int m = 0; m < 4; ++m) { bf16_t* rowp = C + (size_t)(row0 + ai * 128 + m * 16) * DM + col0;
#pragma unroll
                for (int bj = 0; bj < 2; ++bj) { const f32x4 v0 = acc[ai][bj][m][0], v1 = acc[ai][bj][m][1];
                    u32x4 w; w.x = pg8::cvt_pk_bf16(v0[0], v0[1]); w.y = pg8::cvt_pk_bf16(v0[2], v0[3]); w.z = pg8::cvt_pk_bf16(v1[0], v1[1]); w.w = pg8::cvt_pk_bf16(v1[2], v1[3]);
                    *(u32x4*)(rowp + bj * 128) = w; } }
    }
};
struct MoeUnitTab {
    LAS unsigned char* lds; int nun;
    __device__ __forceinline__ bool next(int i, pg8::Unit& u) const {
        if (i >= nun) return false;
        const i32x4 d = *(const LAS i32x4*)(lds + UD_OFF + i * 16);
        u.e = __builtin_amdgcn_readfirstlane(d.x); u.pn = __builtin_amdgcn_readfirstlane(d.y & 0xffff); u.nh = __builtin_amdgcn_readfirstlane(d.y >> 16); u.pm = __builtin_amdgcn_readfirstlane(d.z); u.slot = i;
        const int live = *(const LAS int*)(lds + UD_OFF + 256 + 4 * u.e) - 256 * __builtin_amdgcn_readfirstlane(d.w); u.half = __builtin_amdgcn_readfirstlane(live <= 128 ? 1 : 0); return true;
    }
    __device__ __forceinline__ i32x2 rt(int slot, int row) const { return *(const LAS i32x2*)(lds + RT_OFF + (slot * 256 + row) * 8); }
};
__device__ __forceinline__ float swiglu(float g, float l) {
    const float xg = fminf(g, SW_LIMIT), xl = fminf(fmaxf(l, -SW_LIMIT), SW_LIMIT);
    return xg * __builtin_amdgcn_rcpf(1.0f + __expf(-SW_ALPHA * xg)) * (xl + 1.0f);
}
struct PbGu {
    static constexpr bool PERM = true, FP8 = true, COL16 = false, SWAP16 = true;
    const char* Abase; const char* Wt; MoeUnitTab T; const float* bias; unsigned char* ACT; Frame* Fp; int hook_unit, hook_n;
    __device__ __forceinline__ void hook(int ui) const { if (ui == hook_unit) conv_dn(*Fp, hook_n); }
    __device__ __forceinline__ bool next(int i, pg8::Unit& u) const { return T.next(i, u); }
    __device__ __forceinline__ bool full(const pg8::Unit& u) const { return u.half == 0; }
    __device__ __forceinline__ bool nfull(const pg8::Unit&) const { return true; }
    __device__ __forceinline__ unsigned a_off(const pg8::Unit& u, int row) const { const int dest = T.rt(u.slot, row).x; const int tok = dest < 0 ? 0 : (dest >> 2); return (unsigned)tok * 2048u; }
    __device__ __forceinline__ const char* b_ptr(const pg8::Unit& u) const { return Wt + ((size_t)u.e * 4096 + (size_t)u.pn * 256) * 2048; }
    static constexpr bool BIAS = true;
    __device__ __forceinline__ const float* bias_src(const pg8::Unit& u) const { return bias + (size_t)u.e * 4096 + u.pn * 256; }
    __device__ __forceinline__ void epi(const pg8::Acc& acc, const pg8::Unit& u, int wr, int wc, int fr, int fq, const LAS float* lb) const {
        const int cb = wc * 32 + 16 * (fq & 1) + 8 * (fq >> 1);
        const LAS float* bp = lb + cb;
        f32x4 bg[2], bl[2];
#pragma unroll
        for (int n = 0; n < 2; ++n) { bg[n] = *(const LAS f32x4*)(bp + 4 * n); bl[n] = *(const LAS f32x4*)(bp + 128 + 4 * n); }
        const int acol = u.pn * 128 + wc * 32 + 16 * (fq & 1);
#pragma unroll
        for (int ai = 0; ai < 2; ++ai) {
            if (ai == 1 && u.half) continue;
#pragma unroll
            for (int mp = 0; mp < 4; mp += 2) {
                u32x2 w[2];
#pragma unroll
                for (int k = 0; k < 2; ++k) { const int m = mp + k;
                    const f32x4 g0 = acc[ai][0][m][0] * WQ_INV + bg[0], g1 = acc[ai][0][m][1] * WQ_INV + bg[1], l0 = acc[ai][1][m][0] * WQ_INV + bl[0], l1 = acc[ai][1][m][1] * WQ_INV + bl[1];
                    w[k].x = pk4_fp8(swiglu(g0[0], l0[0]), swiglu(g0[1], l0[1]), swiglu(g0[2], l0[2]), swiglu(g0[3], l0[3]));
                    w[k].y = pk4_fp8(swiglu(g1[0], l1[0]), swiglu(g1[1], l1[1]), swiglu(g1[2], l1[2]), swiglu(g1[3], l1[3])); }
                const auto sx = __builtin_amdgcn_permlane32_swap(w[0].x, w[1].x, false, false), sy = __builtin_amdgcn_permlane32_swap(w[0].y, w[1].y, false, false);
                const int row = u.pm + ai * 128 + wr * 64 + (mp + (fq >> 1)) * 16 + fr;
                *(u32x4*)(ACT + (size_t)row * DFF + acol) = (u32x4){sx[0], sy[0], sx[1], sy[1]}; } }
    }
};
struct PbDn {
    static constexpr bool PERM = true, FP8 = true, COL16 = true, SWAP16 = false;
    const char* Abase; const char* Wt; MoeUnitTab T; const float* bias; unsigned char* YP;
    __device__ __forceinline__ void hook(int) const {}
    __device__ __forceinline__ bool next(int i, pg8::Unit& u) const { return T.next(i, u); }
    __device__ __forceinline__ bool full(const pg8::Unit& u) const { return u.half == 0; }
    __device__ __forceinline__ bool nfull(const pg8::Unit& u) const { return u.nh == 0; }
    __device__ __forceinline__ unsigned a_off(const pg8::Unit& u, int row) const { return (unsigned)(u.pm + row) * 2048u; }
    __device__ __forceinline__ const char* b_ptr(const pg8::Unit& u) const { return Wt + ((size_t)u.e * 2048 + (size_t)u.pn * 256 + (u.nh == 2 ? 8 : 0)) * 2048; }
    static constexpr bool BIAS = true;
    __device__ __forceinline__ const float* bias_src(const pg8::Unit& u) const { return bias + (size_t)u.e * DM + u.pn * 256; }
    __device__ __forceinline__ void epi(const pg8::Acc& acc, const pg8::Unit& u, int wr, int wc, int fr, int fq, const LAS float* lb) const {
        const int col0 = u.pn * 256 + wc * 64 + 16 * fq + (u.nh == 2 ? 8 : 0);
        const LAS float* bp = lb + wc * 64 + 16 * fq + (u.nh == 2 ? 8 : 0);
        f32x4 bv[2][2];
#pragma unroll
        for (int bj = 0; bj < 2; ++bj)
#pragma unroll
            for (int n = 0; n < 2; ++n) bv[bj][n] = *(const LAS f32x4*)(bp + ((bj == 1 && u.nh) ? 0 : bj * 8) + 4 * n);
#pragma unroll
        for (int ai = 0; ai < 2; ++ai)
#pragma unroll
            for (int m = 0; m < 4; ++m) { const i32x2 de = T.rt(u.slot, ai * 128 + wr * 64 + m * 16 + fr);
                if (de.x >= 0) { const int gbits = de.y; const float gt = __int_as_float(gbits) * YP_SCALE;
                    unsigned char* rowp = YP + (size_t)de.x * DM + col0;
                    u32x4 w;
                    { const f32x4 v0 = (acc[ai][0][m][0] * WQ_INV + bv[0][0]) * gt, v1 = (acc[ai][0][m][1] * WQ_INV + bv[0][1]) * gt; w.x = pk4_fp8(v0[0], v0[1], v0[2], v0[3]); w.y = pk4_fp8(v1[0], v1[1], v1[2], v1[3]); }
                    if (u.nh) *(u32x2*)rowp = (u32x2){w.x, w.y};
                    else { const f32x4 v0 = (acc[ai][1][m][0] * WQ_INV + bv[1][0]) * gt, v1 = (acc[ai][1][m][1] * WQ_INV + bv[1][1]) * gt; w.z = pk4_fp8(v0[0], v0[1], v0[2], v0[3]); w.w = pk4_fp8(v1[0], v1[1], v1[2], v1[3]);
                        *(u32x4*)rowp = w; } } }
    }
};
__device__ __forceinline__ int moe_setup(Frame& F, int nN) {
    const int f_tid = tid_id();
    LAS unsigned char* lds = F.lds;
    LAS int* cnt = (LAS int*)(lds + UD_OFF + 256);
    LAS int* tst = cnt + 32;
    LAS int* nunp = tst + 33;
    if (f_tid < 64) {
        const int e = f_tid & 31;
        const int c = (int)__hip_atomic_load(((unsigned*)F.ws) + CW_CNT + 64 * e, __ATOMIC_RELAXED, __HIP_MEMORY_SCOPE_AGENT);
        int incl = (c + 255) >> 8;
#pragma unroll
        for (int o = 1; o < 32; o <<= 1) { const int t = __shfl_up(incl, o, 32); if (e >= o) incl += t; }
        if (f_tid < 32) { cnt[e] = c; tst[e] = incl - ((c + 255) >> 8); if (e == 31) tst[NE] = incl; }
    }
    __syncthreads();
    {
        const int NU = tst[NE] * nN;
        int lo, hi, rank, W;
        if ((F.G & 7) == 0) { const int x = F.bx & 7; W = F.G >> 3; rank = F.bx >> 3; lo = (int)(((long)NU * x) >> 3); hi = (int)(((long)NU * (x + 1)) >> 3); }
        else { W = F.G; rank = F.bx; lo = 0; hi = NU; }
        const int rounds = (hi - lo) / W, tail = (hi - lo) - rounds * W; const bool split = (nN == 8) && tail > 0 && 2 * tail <= W;
        if (W == 32 && hi - lo <= 512) {
            LAS int* wh = nunp + 1;
            const int L = lo + f_tid, w = f_tid >> 5, p = f_tid & 31; const bool valid = L < hi;
            int e = 0, pn = 0, mi = 0; bool hf = false;
            if (valid) { while (e < NE - 1 && tst[e + 1] * nN <= L) ++e;
                const int rem = L - tst[e] * nN, te = tst[e + 1] - tst[e]; pn = rem / te; mi = rem % te; hf = (cnt[e] - 256 * mi) <= 128; }
            const unsigned long long bm = __ballot(valid && hf);
            const unsigned hm = (unsigned)(bm >> (32 * (w & 1)));
            if (p == 0) wh[w] = __popc(hm);
            if (f_tid == 0) wh[16] = 0;
            __syncthreads();
            if (valid) {
                int h0 = 0; for (int i = 0; i < w; ++i) h0 += wh[i];
                const int nh = __popc(hm), below = __popc(hm & ((1u << p) - 1u));
                bool take; int sub = 0;
                if (w == rounds && split) { take = (rank >> 1) == p && rank < 2 * tail; sub = 1 + (rank & 1); }
                else { int r; if (hf) r = (h0 + below) & 31; else { const int f = p - below, a0 = h0 & 31; r = (a0 + nh <= 32) ? (f < a0 ? f : f + nh) : f + (a0 + nh - 32); } take = (r == rank); }
                if (take) { *(LAS i32x4*)(lds + UD_OFF + w * 16) = (i32x4){e, pn | (sub << 16), 256 * (tst[e] + mi), mi}; if (w == rounds) wh[16] = 1; }
            }
            __syncthreads();
            if (f_tid == 0) *nunp = rounds + wh[16];
        } else if (f_tid == 0) {
            int n = 0;
            for (int i = 0; i < RT_SLOTS; ++i) { int L, sub = 0;
                if (i < rounds) L = lo + rank + i * W;
                else if (i == rounds && split) { if (rank >= 2 * tail) break; L = lo + rounds * W + (rank >> 1); sub = 1 + (rank & 1); }
                else if (i == rounds) { if (rank >= tail) break; L = lo + rounds * W + rank; }
                else break;
                int e = 0; while (e < NE - 1 && tst[e + 1] * nN <= L) ++e;
                const int rem = L - tst[e] * nN, te = tst[e + 1] - tst[e], pn = rem / te, mi = rem % te;
                *(LAS i32x4*)(lds + UD_OFF + i * 16) = (i32x4){e, pn | (sub << 16), 256 * (tst[e] + mi), mi}; ++n; }
            *nunp = n;
        }
    }
    __syncthreads();
    const int nun = *nunp;
    const int* LIST = WSP(const int, WS_LIST); const float* GATE = WSP(const float, WS_GATE);
    {
        constexpr int EPT = RT_SLOTS * 256 / 512;
        const int nent = nun * 256; int dst[EPT]; float gg[EPT];
#pragma unroll
        for (int k = 0; k < EPT; ++k) { const int idx = f_tid + 512 * k; dst[k] = -1;
            if (idx < nent) { const i32x4 d = *(const LAS i32x4*)(lds + UD_OFF + (idx >> 8) * 16); const int pos = d.w * 256 + (idx & 255); if (pos < cnt[d.x]) dst[k] = LIST[d.x * NTOK + pos]; } }
#pragma unroll
        for (int k = 0; k < EPT; ++k) gg[k] = dst[k] >= 0 ? GATE[dst[k]] : 0.f;
#pragma unroll
        for (int k = 0; k < EPT; ++k) { const int idx = f_tid + 512 * k; if (idx < nent) *(LAS i32x2*)(lds + RT_OFF + idx * 8) = (i32x2){dst[k], __builtin_bit_cast(int, gg[k])}; }
    }
    __syncthreads();
    return nun;
}

template <int MODE>
__device__ __forceinline__ void p0_transpose_item(const float* W, int ldw, bf16_t* WT, int k0, int n0, LAS float* scr, int lane) {
    const int src0 = (MODE == 1) ? (n0 >= 3072 ? n0 + 8 : n0) : n0;
#pragma unroll 8
    for (int i = 0; i < 32; ++i) { const int kk = 2 * i + (lane >> 5); scr[kk * 33 + (lane & 31)] = W[(size_t)(k0 + kk) * ldw + src0 + (lane & 31)]; }
    LDS_WAIT(); asm volatile("" ::: "memory");
    const int c = lane & 7;
#pragma unroll
    for (int j = 0; j < 4; ++j) { const int n = (lane >> 3) + 8 * j; const LAS float* s = scr + (8 * c) * 33 + n;
        u32x4 o; o.x = pk2(s[0 * 33], s[1 * 33]); o.y = pk2(s[2 * 33], s[3 * 33]); o.z = pk2(s[4 * 33], s[5 * 33]); o.w = pk2(s[6 * 33], s[7 * 33]);
        int orow;
        if (MODE == 2) { const int col = n0 + n, jj = col >> 1; orow = 256 * (jj >> 7) + (jj & 127) + 128 * (col & 1); } else orow = n0 + n;
        *(u32x4*)(WT + (size_t)orow * 2048 + k0 + 8 * c) = o; }
    LDS_WAIT(); asm volatile("" ::: "memory");
}
template <int MODE>
__device__ __forceinline__ void conv_store(const f32x4 (&v)[16], unsigned char* WT, int k0, int n0, int lane) {
    const int kg = lane & 7, ng = lane >> 3;
#pragma unroll
    for (int i = 0; i < 4; ++i) {
        u32x4 o;
        o.x = pk4_fp8(v[0][i] * WQ_SCALE, v[1][i] * WQ_SCALE, v[2][i] * WQ_SCALE, v[3][i] * WQ_SCALE);
        o.y = pk4_fp8(v[4][i] * WQ_SCALE, v[5][i] * WQ_SCALE, v[6][i] * WQ_SCALE, v[7][i] * WQ_SCALE);
        o.z = pk4_fp8(v[8][i] * WQ_SCALE, v[9][i] * WQ_SCALE, v[10][i] * WQ_SCALE, v[11][i] * WQ_SCALE);
        o.w = pk4_fp8(v[12][i] * WQ_SCALE, v[13][i] * WQ_SCALE, v[14][i] * WQ_SCALE, v[15][i] * WQ_SCALE);
        const int col = n0 + 4 * ng + i; int orow;
        if (MODE == 2) { const int jj = col >> 1; orow = 256 * (jj >> 7) + (jj & 127) + 128 * (col & 1); } else orow = col;
        __builtin_nontemporal_store(o, (u32x4*)(WT + (size_t)orow * 2048 + k0 + 16 * kg)); }
}
__device__ __forceinline__ void conv_load(f32x4 (&v)[16], const float* W, int ldw, int k0, int n0, int lane) {
    const int kg = lane & 7, ng = lane >> 3;
    const float* src = W + (size_t)(k0 + 16 * kg) * ldw + n0 + 4 * ng;
#pragma unroll
    for (int j = 0; j < 16; ++j) v[j] = __builtin_nontemporal_load((const f32x4*)(src + (size_t)j * ldw));
}
constexpr int CV_GU_ITEMS = NE * 16 * 128, CV_DN_ITEMS = NE * 16 * 64;
__device__ __forceinline__ void conv_gu(Frame& F, int n) {
    const int f_lane = lane_id();
    const float* w = FIN(I_WGU); unsigned char* WT = WSP(unsigned char, WS_WGU_T);
    const int NGW = (F.G >> 2) * 8, gw = ((((F.bx >> 5) << 3) | (F.bx & 7)) * 8 + F.wave) + F.cgrp * (CV_GU_ITEMS / 4);
    for (int i = 0; i < n; i += 2) { const int it0 = gw + F.cgu * NGW, it1 = it0 + NGW; if (it1 >= (F.cgrp + 1) * (CV_GU_ITEMS / 4)) break; F.cgu += 2;
        const int e0 = it0 >> 11, q0 = it0 & 2047, e1 = it1 >> 11, q1 = it1 & 2047;
        f32x4 va[16], vb[16];
        conv_load(va, w + (size_t)e0 * DM * 4096, 4096, (q0 >> 7) * 128, (q0 & 127) * 32, f_lane);
        conv_load(vb, w + (size_t)e1 * DM * 4096, 4096, (q1 >> 7) * 128, (q1 & 127) * 32, f_lane);
        conv_store<2>(va, WT + (size_t)e0 * 4096 * 2048, (q0 >> 7) * 128, (q0 & 127) * 32, f_lane);
        conv_store<2>(vb, WT + (size_t)e1 * 4096 * 2048, (q1 >> 7) * 128, (q1 & 127) * 32, f_lane); }
}
__device__ __forceinline__ void conv_dn(Frame& F, int n) {
    const int f_lane = lane_id();
    const float* w = FIN(I_WDN); unsigned char* WT = WSP(unsigned char, WS_WDN_T);
    const int NGW = (F.G >> 2) * 8, gw = ((((F.bx >> 5) << 3) | (F.bx & 7)) * 8 + F.wave) + F.cgrp * (CV_DN_ITEMS / 4);
    for (int i = 0; i < n; i += 2) { const int it0 = gw + F.cdn * NGW, it1 = it0 + NGW; if (it1 >= (F.cgrp + 1) * (CV_DN_ITEMS / 4)) break; F.cdn += 2;
        const int e0 = it0 >> 10, q0 = it0 & 1023, e1 = it1 >> 10, q1 = it1 & 1023;
        f32x4 va[16], vb[16];
        conv_load(va, w + (size_t)e0 * DFF * DM, DM, (q0 >> 6) * 128, (q0 & 63) * 32, f_lane);
        conv_load(vb, w + (size_t)e1 * DFF * DM, DM, (q1 >> 6) * 128, (q1 & 63) * 32, f_lane);
        conv_store<0>(va, WT + (size_t)e0 * DM * 2048, (q0 >> 6) * 128, (q0 & 63) * 32, f_lane);
        conv_store<0>(vb, WT + (size_t)e1 * DM * 2048, (q1 >> 6) * 128, (q1 & 63) * 32, f_lane); }
}
__device__ __forceinline__ void p0_prologue(Frame& F) {
    const int f_tid = tid_id();
    const int f_lane = lane_id();
    const float* in_router_w = FIN(I_RW);
    const float* in_w_ada = FIN(I_WADA);
    const float* in_b_ada = FIN(I_BADA);
    const float* in_w_out = FIN(I_WOUT);
    const float* in_w_in = FIN(I_WIN);
    const float* in_b_in = FIN(I_BIN);
    const float* in_w_gu = FIN(I_WGU);
    const float* in_b_gu = FIN(I_BGU);
    const float* in_w_dn = FIN(I_WDN);
    const float* in_c = FIN(I_C);
    LAS unsigned char* lds = F.lds;
    {
        LAS float* sil = (LAS float*)lds;
        LAS float* red = (LAS float*)(lds + 32768);
        for (int i = f_tid; i < NB * DM; i += 512) { const float v = in_c[i]; sil[i] = v / (1.0f + __expf(-v)); }
        __syncthreads();
        float* MOD = (float*)(((unsigned*)F.ws) + CW_MOD);
        const int cg = f_tid % 12, ks = f_tid / 12;
        for (int it = F.bx; it < MOD_W / 48; it += F.G) {
            const int col0 = it * 48;
            f32x4 a[NB];
#pragma unroll
            for (int b = 0; b < NB; ++b) a[b] = (f32x4){0.f, 0.f, 0.f, 0.f};
            if (ks < 42) {
#pragma unroll 4
                for (int row = ks; row < DM; row += 42) {
                    const f32x4 w = __builtin_nontemporal_load((const f32x4*)(in_w_ada + (size_t)row * MOD_W + col0 + cg * 4));
#pragma unroll
                    for (int b = 0; b < NB; ++b) a[b] += w * sil[b * DM + row]; }
#pragma unroll
                for (int b = 0; b < NB; ++b) *(LAS f32x4*)(red + (ks * NB + b) * 48 + cg * 4) = a[b];
            }
            __syncthreads();
            if (f_tid < NB * 48) { const int b = f_tid / 48, cc = f_tid % 48; float sum = in_b_ada[col0 + cc];
                for (int q = 0; q < 42; ++q) sum += red[(q * NB + b) * 48 + cc];
                MOD[b * MOD_W + col0 + cc] = sum; }
            __syncthreads();
        }
    }
    {
        const int gt = F.bx * 512 + f_tid, NT_ = F.G * 512;
        float* BIN2 = WSP(float, WS_BIN2); float* BGU2 = WSP(float, WS_BGU2); bf16_t* RWT = WSP(bf16_t, WS_RWT);
        for (int i = gt; i < NPJ; i += NT_) BIN2[i] = in_b_in[i >= 3072 ? i + 8 : i];
        for (int i = gt; i < NE * 4096; i += NT_) { const int e = i >> 12, w = i & 4095, pn = w >> 8, q = w & 255, j = pn * 128 + (q & 127); BGU2[i] = in_b_gu[(size_t)e * 4096 + 2 * j + (q >> 7)]; }
        for (int i = gt; i < NE * DM; i += NT_) { const int e = i >> 11, d = i & 2047; RWT[i] = (bf16_t)f2bf(in_router_w[(size_t)d * NE + e]); }
    }
    {
        LAS float* scr = (LAS float*)(lds + F.wave * 8448);
        const int gw = F.bx * 8 + F.wave, NGW = F.G * 8;
        constexpr int I_IN = 32 * (NPJ / 32), I_OUT = 32 * (DM / 32);
        constexpr int NITEMS = I_IN + I_OUT;
        bf16_t* WIN_T = WSP(bf16_t, WS_WIN_T); bf16_t* WOUT_T = WSP(bf16_t, WS_WOUT_T);
        for (int it = gw; it < NITEMS; it += NGW) {
            int r = it;
            if (r < I_IN) { const int nb = r % (NPJ / 32), kb = r / (NPJ / 32); p0_transpose_item<1>(in_w_in, PJ_SRC, WIN_T, kb * 64, nb * 32, scr, f_lane); continue; } r -= I_IN;
            { const int nb = r % (DM / 32), kb = r / (DM / 32); p0_transpose_item<0>(in_w_out, DM, WOUT_T, kb * 64, nb * 32, scr, f_lane); }
        }
    }
}

__device__ __forceinline__ void p1_modulate(Frame& F) {
    const int f_tid = tid_id();
    const int f_lane = lane_id();
    const float* in_w_in = FIN(I_WIN);
    const float* in_b_in = FIN(I_BIN);
    const float* in_x = FIN(I_X);
    LAS float* wg = (LAS float*)F.lds;
    for (int i = f_tid; i < DM * 2; i += 512) { const int d = i >> 1, hf = i & 1; const f32x4 v = *(const f32x4*)(in_w_in + (size_t)d * PJ_SRC + 3072 + hf * 4);
#pragma unroll
        for (int q = 0; q < 4; ++q) wg[(hf * 4 + q) * DM + d] = v[q]; }
    const float* MOD = (const float*)(((unsigned*)F.ws) + CW_MOD);
    LAS float* smod = wg + 8 * DM;
#pragma unroll
    for (int b = 0; b < NB; ++b) { *(LAS f32x4*)(smod + b * 2 * DM + 4 * f_tid) = *(const f32x4*)(MOD + b * MOD_W + 4 * f_tid); *(LAS f32x4*)(smod + b * 2 * DM + DM + 4 * f_tid) = *(const f32x4*)(MOD + b * MOD_W + DM + 4 * f_tid) + 1.0f; }
    __syncthreads();
    bf16_t* H = WSP(bf16_t, WS_H); float* GATES = WSP(float, WS_GATES);
    const int gw = F.bx * 8 + F.wave, NGW = F.G * 8;
    for (int m = gw; m < NTOK; m += NGW) {
        const int b = m / SEQ;
        const float* xr = in_x + (size_t)m * DM; const LAS float* sh = smod + b * 2 * DM; const LAS float* sc = sh + DM;
        float g[8];
#pragma unroll
        for (int q = 0; q < 8; ++q) g[q] = 0.f;
#pragma unroll 2
        for (int j = 0; j < 8; ++j) { const int d = 256 * j + 4 * f_lane;
            const f32x4 xv = *(const f32x4*)(xr + d), s1 = *(const LAS f32x4*)(sc + d), h1 = *(const LAS f32x4*)(sh + d);
            const f32x4 hv = xv * s1 + h1;
            u32x2 o; o.x = pk2(hv[0], hv[1]); o.y = pk2(hv[2], hv[3]);
            *(u32x2*)(H + (size_t)m * DM + d) = o;
#pragma unroll
            for (int q = 0; q < 8; ++q) { const f32x4 w = *(const LAS f32x4*)(wg + q * DM + d); g[q] += (hv[0] * w[0] + hv[1] * w[1]) + (hv[2] * w[2] + hv[3] * w[3]); } }
#pragma unroll
        for (int q = 0; q < 8; ++q) g[q] = wave_sum(g[q]);
        if (f_lane < 8) { float v = g[0];
#pragma unroll
            for (int q = 1; q < 8; ++q) v = (f_lane == q) ? g[q] : v;
            GATES[(size_t)m * 8 + f_lane] = v + in_b_in[3072 + f_lane]; }
    }
}

__device__ __forceinline__ void p7_ln1_router(Frame& F) {
    const int f_tid = tid_id();
    const int f_lane = lane_id();
    const float* in_router_b = FIN(I_RB);
    const float* in_ln1_g = FIN(I_LN1G);
    const float* in_ln1_b = FIN(I_LN1B);
    const float* in_x = FIN(I_X);
    const float* MOD = (const float*)(((unsigned*)F.ws) + CW_MOD);
    const bf16_t* Y1 = WSP(const bf16_t, WS_Y1); bf16_t* X1 = WSP(bf16_t, WS_X1); unsigned char* H2Q = WSP(unsigned char, WS_H2Q);
    const bf16_t* RWT = WSP(const bf16_t, WS_RWT); int* LIST = WSP(int, WS_LIST); float* GATE = WSP(float, WS_GATE);
    LAS float* part = (LAS float*)F.lds;
    constexpr int H2P = DM + 8;
    LAS bf16_t* h2t = (LAS bf16_t*)F.lds;
    const int r32 = f_lane & 31, hi = f_lane >> 5;
    for (int it = F.bx; it < NTOK / 32; it += F.G) {
        const int t0 = it * 32, b = t0 / SEQ;
        const float* mb = MOD + b * MOD_W;
        u32x2 ywA[8], ywB[8]; f32x4 xvA[8], xvB[8];
#define P7_LOAD(YW, XV, rr_) do { const int m_ = t0 + F.wave * 4 + (rr_); _Pragma("unroll") for (int j = 0; j < 8; ++j) { const int d = 256 * j + 4 * f_lane; \
            YW[j] = __builtin_nontemporal_load((const u32x2*)(Y1 + (size_t)m_ * DM + d)); XV[j] = __builtin_nontemporal_load((const f32x4*)(in_x + (size_t)m_ * DM + d)); } } while (0)
#define P7_TOKEN(YW, XV, rr_) do { const int rr = (rr_), m = t0 + F.wave * 4 + rr; int fl_ = f_lane; asm volatile("" : "+v"(fl_));   \
            f32x4 v[8]; float s = 0.f; \
            _Pragma("unroll") for (int j = 0; j < 8; ++j) { const int d = 256 * j + 4 * fl_; \
                const f32x4 yv = (f32x4){bflo(YW[j].x), bfhi(YW[j].x), bflo(YW[j].y), bfhi(YW[j].y)}, g1 = *(const f32x4*)(mb + 2 * DM + d); \
                v[j] = XV[j] * DN_ALPHA + (g1 + 1.0f) * yv; s += (v[j][0] + v[j][1]) + (v[j][2] + v[j][3]); } \
            const float mean = wave_sum(s) * (1.0f / DM); float s2 = 0.f; \
            _Pragma("unroll") for (int j = 0; j < 8; ++j) { v[j] = v[j] - mean; s2 += (v[j][0] * v[j][0] + v[j][1] * v[j][1]) + (v[j][2] * v[j][2] + v[j][3] * v[j][3]); } \
            const float rstd = 1.0f / sqrtf(wave_sum(s2) * (1.0f / DM) + LN_EPS); \
            _Pragma("unroll") for (int j = 0; j < 8; ++j) { const int d = 256 * j + 4 * fl_; \
                const f32x4 gg = *(const f32x4*)(in_ln1_g + d), bb = *(const f32x4*)(in_ln1_b + d), sc2 = *(const f32x4*)(mb + 4 * DM + d), sh2 = *(const f32x4*)(mb + 3 * DM + d); \
                const f32x4 x1 = v[j] * rstd * gg + bb; \
                { u32x2 xo; xo.x = pk2(x1[0], x1[1]); xo.y = pk2(x1[2], x1[3]); *(u32x2*)(X1 + (size_t)m * DM + d) = xo; } \
                const f32x4 h2 = x1 * (sc2 + 1.0f) + sh2; \
                u32x2 o; o.x = pk2(h2[0], h2[1]); o.y = pk2(h2[2], h2[3]); \
                *(LAS u32x2*)(h2t + (F.wave * 4 + rr) * H2P + d) = o; \
                *(unsigned*)(H2Q + (size_t)m * DM + d) = pk4_fp8(h2[0], h2[1], h2[2], h2[3]); } } while (0)
        P7_LOAD(ywA, xvA, 0);
#pragma unroll 1
        for (int rp = 0; rp < 4; rp += 2) {
            P7_LOAD(ywB, xvB, rp + 1);
            P7_TOKEN(ywA, xvA, rp);
            if (rp + 2 < 4) P7_LOAD(ywA, xvA, rp + 2);
            P7_TOKEN(ywB, xvB, rp + 1);
        }
#undef P7_LOAD
#undef P7_TOKEN
        __syncthreads();
        {
            f32x16 acc = {};
            const LAS bf16_t* ap = h2t + r32 * H2P + F.wave * 256 + hi * 8;
            const bf16_t* bp = RWT + (size_t)r32 * DM + F.wave * 256 + hi * 8;
#pragma unroll
            for (int s = 0; s < 16; ++s) { const bf16x8 a = *(const LAS bf16x8*)(ap + 16 * s), bq = *(const bf16x8*)(bp + 16 * s);
                acc = __builtin_amdgcn_mfma_f32_32x32x16_bf16(a, bq, acc, 0, 0, 0); }
            __syncthreads();
#pragma unroll
            for (int i = 0; i < 16; ++i) { const int tok = (i & 3) + 8 * (i >> 2) + 4 * hi; part[(F.wave * 32 + tok) * 33 + r32] = acc[i]; }
        }
        __syncthreads();
        LAS float* lgs = part + 8 * 32 * 33;
#pragma unroll
        for (int q = 0; q < 2; ++q) { const int idx = f_tid + 512 * q, tk = idx >> 5, e = idx & 31; float s = in_router_b[e];
#pragma unroll
            for (int w = 0; w < 8; ++w) s += part[(w * 32 + tk) * 33 + e];
            lgs[tk * 33 + e] = s; }
        __syncthreads();
        if (f_tid < 32) {
            float lg[NE];
#pragma unroll
            for (int e = 0; e < NE; ++e) lg[e] = lgs[f_tid * 33 + e];
            float tv[TOPK]; int ti[TOPK];
#pragma unroll
            for (int k = 0; k < TOPK; ++k) { float best = -INFINITY; int bi = 0;
#pragma unroll
                for (int e = 0; e < NE; ++e) { const bool tk = lg[e] > best; best = tk ? lg[e] : best; bi = tk ? e : bi; }
                tv[k] = best; ti[k] = bi;
#pragma unroll
                for (int e = 0; e < NE; ++e) lg[e] = (e == bi) ? -INFINITY : lg[e]; }
            float ex[TOPK], den = 0.f;
#pragma unroll
            for (int k = 0; k < TOPK; ++k) { ex[k] = __expf(tv[k] - tv[0]); den += ex[k]; }
            const int tok = t0 + f_tid;
            LAS unsigned* ecnt = (LAS unsigned*)(F.lds + UD_OFF);
            ecnt[f_tid] = 0u; LDS_WAIT();
            unsigned lp[TOPK];
#pragma unroll
            for (int k = 0; k < TOPK; ++k) lp[k] = __hip_atomic_fetch_add(ecnt + ti[k], 1u, __ATOMIC_RELAXED, __HIP_MEMORY_SCOPE_WORKGROUP);
            LDS_WAIT();
            const unsigned mine = ecnt[f_tid];
            const unsigned base = mine ? xb_add(((unsigned*)F.ws) + CW_CNT + 64 * f_tid, mine) : 0u;
            LDS_WAIT(); ecnt[f_tid] = base; LDS_WAIT();
#pragma unroll
            for (int k = 0; k < TOPK; ++k) { const int pos = (int)(ecnt[ti[k]] + lp[k]);
                LIST[ti[k] * NTOK + pos] = tok * 4 + k; GATE[tok * 4 + k] = ex[k] / den; }
        }
        __syncthreads();
    }
}

__device__ __forceinline__ void p10_ln2(Frame& F) {
    const int f_lane = lane_id();
    const float* in_ln2_g = FIN(I_LN2G);
    const float* in_ln2_b = FIN(I_LN2B);
    const float* MOD = (const float*)(((unsigned*)F.ws) + CW_MOD);
    const bf16_t* X1 = WSP(const bf16_t, WS_X1); const unsigned char* YP = WSP(const unsigned char, WS_YP);
    float* outp = F.outp[opq(0)];
    LAS float* sg2 = (LAS float*)F.lds;
    LAS float* sgg = sg2 + NB * DM; LAS float* sbb = sgg + DM;
    { const int f_tid = tid_id();
#pragma unroll
      for (int b = 0; b < NB; ++b) *(LAS f32x4*)(sg2 + b * DM + 4 * f_tid) = *(const f32x4*)(MOD + b * MOD_W + 5 * DM + 4 * f_tid) + 1.0f;
      *(LAS f32x4*)(sgg + 4 * f_tid) = *(const f32x4*)(in_ln2_g + 4 * f_tid); *(LAS f32x4*)(sbb + 4 * f_tid) = *(const f32x4*)(in_ln2_b + 4 * f_tid); }
    __syncthreads();
    const int gw = F.bx * 8 + F.wave, NGW = F.G * 8;
    for (int m = gw; m < NTOK; m += NGW) {
        const int b = m / SEQ; const LAS float* mb = sg2 + b * DM;
        f32x4 v[8]; float s = 0.f;
#pragma unroll
        for (int j = 0; j < 8; ++j) { const int d = 256 * j + 4 * f_lane;
            f32x4 y = {0.f, 0.f, 0.f, 0.f};
#pragma unroll
            for (int k = 0; k < TOPK; ++k) { const unsigned w = __builtin_nontemporal_load((const unsigned*)(YP + (size_t)(m * 4 + k) * DM + d)); const f32x2 lo = __builtin_amdgcn_cvt_pk_f32_fp8((int)w, false), hi2 = __builtin_amdgcn_cvt_pk_f32_fp8((int)w, true); y[0] += lo[0]; y[1] += lo[1]; y[2] += hi2[0]; y[3] += hi2[1]; }
            y = y * YP_INV;
            const u32x2 xw = __builtin_nontemporal_load((const u32x2*)(X1 + (size_t)m * DM + d)); const f32x4 xv = (f32x4){bflo(xw.x), bfhi(xw.x), bflo(xw.y), bfhi(xw.y)}, g2 = *(const LAS f32x4*)(mb + d);
            v[j] = xv * DN_ALPHA + g2 * y; s += (v[j][0] + v[j][1]) + (v[j][2] + v[j][3]); }
        const float mean = wave_sum(s) * (1.0f / DM); float s2 = 0.f;
#pragma unroll
        for (int j = 0; j < 8; ++j) { v[j] = v[j] - mean; s2 += (v[j][0] * v[j][0] + v[j][1] * v[j][1]) + (v[j][2] * v[j][2] + v[j][3] * v[j][3]); }
        const float rstd = 1.0f / sqrtf(wave_sum(s2) * (1.0f / DM) + LN_EPS);
#pragma unroll
        for (int j = 0; j < 8; ++j) { const int d = 256 * j + 4 * f_lane;
            const f32x4 gg = *(const LAS f32x4*)(sgg + d), bb = *(const LAS f32x4*)(sbb + d);
            __builtin_nontemporal_store(v[j] * rstd * gg + bb, (f32x4*)(outp + (size_t)m * DM + d)); }
    }
}

namespace attn_body {
constexpr int D = 64, PQ = NPJ, PO = DM;
constexpr int NW = 8, QBLK = 32, QB = QBLK * NW, KVBLK = 64, NQB = SEQ / QB;
__device__ __forceinline__ int crow(int r, int hi) { return (r & 3) + 8 * (r >> 2) + 4 * hi; }
#define SBAR() __builtin_amdgcn_sched_barrier(0)
__device__ __forceinline__ float bias1(int d, float s2) {
    const int cnt = (int)((unsigned)d <= 128u) + (int)(((d & 3) == 0) & ((unsigned)d <= 512u)) + (int)(((d & 15) == 0) & (d >= 0));
    const float lm = cnt == 0 ? -INFINITY : (cnt == 1 ? 0.f : (cnt == 2 ? 1.f : 1.5849625007f));
    return lm - s2 * (float)d;
}
constexpr int ABT_N = 2304, ABT_OFF = 256;
constexpr int ABT_COPY = ABT_N * 4 + 64;
__device__ __forceinline__ void abias_tab(f32x16& p0, f32x16& p1, unsigned ta  , float mh) {
    f32x4 q[8];
    asm volatile("ds_read_b128 %0, %8 offset:0\n\tds_read_b128 %1, %8 offset:32\n\tds_read_b128 %2, %8 offset:64\n\tds_read_b128 %3, %8 offset:96\n\t"
                 "ds_read_b128 %4, %8 offset:128\n\tds_read_b128 %5, %8 offset:160\n\tds_read_b128 %6, %8 offset:192\n\tds_read_b128 %7, %8 offset:224\n\ts_waitcnt lgkmcnt(0)"
                 : "=&v"(q[0]), "=&v"(q[1]), "=&v"(q[2]), "=&v"(q[3]), "=&v"(q[4]), "=&v"(q[5]), "=&v"(q[6]), "=&v"(q[7]) : "v"(ta) : "memory");
#pragma unroll
    for (int g = 0; g < 4; ++g)
#pragma unroll
        for (int i = 0; i < 4; ++i) { p0[4 * g + i] += q[g][i] - mh; p1[4 * g + i] += q[4 + g][i] - mh; }
}
constexpr int NSLOT = 3, SLOTB = 8192;
constexpr int LDS_K = 0, LDS_V = NSLOT * SLOTB, LDS_WS = 2 * NSLOT * SLOTB, LDS_OST = LDS_WS + NW * 64 * 4, LDS_TAB = LDS_OST + NW * 4096, LDS_BYTES_A = LDS_TAB + 4 * (2304 * 4 + 64);
__device__ __forceinline__ void glds16(const void* sbase, unsigned voff, unsigned lds_dst) { unsigned keep;
    asm volatile("s_mov_b32 %0, m0\n\ts_mov_b32 m0, %3\n\ts_nop 0\n\tglobal_load_lds_dwordx4 %1, %2\n\ts_mov_b32 m0, %0" : "=&s"(keep) : "v"(voff), "s"(sbase), "s"(lds_dst) : "memory"); }
__device__ __forceinline__ float max3f(float a, float b, float c) { float r; asm("v_max3_f32 %0, %1, %2, %3" : "=v"(r) : "v"(a), "v"(b), "v"(c)); return r; }
__device__ __forceinline__ float max2f(float a, float b) { float r; asm("v_max_f32_e32 %0, %1, %2" : "=v"(r) : "v"(a), "v"(b)); return r; }
__device__ __forceinline__ float fadd_s(float a, float b) { float r; asm("v_add_f32_e32 %0, %1, %2" : "=v"(r) : "v"(a), "v"(b)); return r; }
__device__ __forceinline__ float fsub_s(float a, float b) { float r; asm("v_sub_f32_e32 %0, %1, %2" : "=v"(r) : "v"(a), "v"(b)); return r; }
typedef __bf16 bf16x2_t __attribute__((ext_vector_type(2)));
__device__ __forceinline__ unsigned cvtpk_s(float lo, float hi) { f32x2 v = {lo, hi}; bf16x2_t b = __builtin_convertvector(v, bf16x2_t); return __builtin_bit_cast(unsigned, b); }
#define WAIT_BAR(N) asm volatile("s_waitcnt vmcnt(" #N ") lgkmcnt(0)\n\ts_barrier" ::: "memory")
__device__ __forceinline__ void qkt(f32x16& p0, f32x16& p1, const char* Kslot, const bf16x8* qr, const f32x16& negm, int r32, int hi) {
    const char* kb = Kslot + hi * 1024 + r32 * 16;
#pragma unroll
    for (int d0 = 0; d0 < 4; ++d0) {
        const bf16x8 b0 = *reinterpret_cast<const bf16x8*>(kb + d0 * 2048);
        const bf16x8 b1 = *reinterpret_cast<const bf16x8*>(kb + d0 * 2048 + 512);
        if (d0 == 0) { p0 = __builtin_amdgcn_mfma_f32_32x32x16_bf16(b0, qr[0], negm, 0, 0, 0); p1 = __builtin_amdgcn_mfma_f32_32x32x16_bf16(b1, qr[0], negm, 0, 0, 0); }
        else { p0 = __builtin_amdgcn_mfma_f32_32x32x16_bf16(b0, qr[d0], p0, 0, 0, 0); p1 = __builtin_amdgcn_mfma_f32_32x32x16_bf16(b1, qr[d0], p1, 0, 0, 0); } }
}
typedef __attribute__((address_space(3))) const char* lds_cptr;
typedef short v4i16_t __attribute__((ext_vector_type(4)));
__device__ __forceinline__ void kload8(bf16x8* kf, lds_cptr kp) {
    kf[0] = *(const LAS bf16x8*)(kp);        kf[1] = *(const LAS bf16x8*)(kp + 512);
    kf[2] = *(const LAS bf16x8*)(kp + 2048); kf[3] = *(const LAS bf16x8*)(kp + 2560);
    kf[4] = *(const LAS bf16x8*)(kp + 4096); kf[5] = *(const LAS bf16x8*)(kp + 4608);
    kf[6] = *(const LAS bf16x8*)(kp + 6144); kf[7] = *(const LAS bf16x8*)(kp + 6656);
}
__device__ __forceinline__ void kload2(bf16x8* kf, lds_cptr kp, int j) { kf[2 * j] = *(const LAS bf16x8*)(kp + j * 2048); kf[2 * j + 1] = *(const LAS bf16x8*)(kp + j * 2048 + 512); }
__device__ __forceinline__ s16x4 vtr(lds_cptr p) { return __builtin_bit_cast(s16x4, __builtin_amdgcn_ds_read_tr16_b64_v4i16((LAS v4i16_t*)p)); }
__device__ __forceinline__ float rowmax(const f32x16& p0, const f32x16& p1) {
    float a = max3f(p0[0], p0[1], p1[0]), b = max3f(p0[2], p0[3], p1[1]); a = max3f(a, p1[2], p1[3]);
#pragma unroll
    for (int r = 4; r < 16; r += 4) { a = max3f(a, p0[r], p0[r + 1]); b = max3f(b, p0[r + 2], p0[r + 3]); a = max3f(a, p1[r], p1[r + 1]); b = max3f(b, p1[r + 2], p1[r + 3]); }
    const float m = max2f(a, b);
    auto rr = __builtin_amdgcn_permlane32_swap(__float_as_uint(m), __float_as_uint(m), false, false);
    return max2f(__uint_as_float(rr[0]), __uint_as_float(rr[1]));
}
__device__ __forceinline__ void pv(f32x16* o, int vb, bf16x8 pa0, bf16x8 pa1, bf16x8 pa2, bf16x8 pa3) {
#pragma unroll
    for (int d0 = 0; d0 < 2; ++d0) { s16x4 lo[4], hi[4];
#pragma unroll
        for (int ks = 0; ks < 4; ++ks) {
            asm volatile("ds_read_b64_tr_b16 %0,%1 offset:%c2" : "=&v"(lo[ks]) : "v"(vb), "i"(d0 * 4096 + ks * 1024) : "memory");
            asm volatile("ds_read_b64_tr_b16 %0,%1 offset:%c2" : "=&v"(hi[ks]) : "v"(vb), "i"(d0 * 4096 + ks * 1024 + 512) : "memory"); }
        asm volatile("s_waitcnt lgkmcnt(0)" ::: "memory"); SBAR();
#define PK(k) (bf16x8){lo[k][0], lo[k][1], lo[k][2], lo[k][3], hi[k][0], hi[k][1], hi[k][2], hi[k][3]}
        o[d0] = __builtin_amdgcn_mfma_f32_32x32x16_bf16(pa0, PK(0), o[d0], 0, 0, 0);
        o[d0] = __builtin_amdgcn_mfma_f32_32x32x16_bf16(pa1, PK(1), o[d0], 0, 0, 0);
        o[d0] = __builtin_amdgcn_mfma_f32_32x32x16_bf16(pa2, PK(2), o[d0], 0, 0, 0);
        o[d0] = __builtin_amdgcn_mfma_f32_32x32x16_bf16(pa3, PK(3), o[d0], 0, 0, 0);
#undef PK
    }
}
template <int THRL> __device__ __forceinline__ void attn_unit(int qb, const bf16_t* Qh, const bf16_t* __restrict__ Kh, const bf16_t* __restrict__ Vh, bf16_t* Oh, const float* gn, float slope2, char* shm) {
    const int tid = threadIdx.x; int lane_o = tid & 63; asm volatile("" : "+v"(lane_o));
    const int lane = lane_o, r32 = lane & 31, hi = lane >> 5; const int wid = __builtin_amdgcn_readfirstlane(tid >> 6);
    const int q0 = qb * QB;
    const bf16_t* Qw = Qh + (long)(q0 + wid * QBLK) * PQ;
    const unsigned lds0 = (unsigned)(uintptr_t)shm;
    float* wsf = (float*)(shm + LDS_WS) + wid * 64;
    const unsigned koff = (unsigned)(lane * PQ + wid * 8) * 2u;
    const unsigned voff = (unsigned)((16 * (wid & 3) + (lane >> 2)) * PQ + (wid >> 2) * 32 + (lane & 3) * 8) * 2u;
    const unsigned kdst = lds0 + LDS_K + wid * 1024, vdst = lds0 + LDS_V + wid * 1024;
#define DMA_K(t, slot) glds16(Kh + (long)(t) * KVBLK * PQ, koff, (unsigned)__builtin_amdgcn_readfirstlane(kdst + (slot)))
#define DMA_V(t, slot) glds16(Vh + (long)(t) * KVBLK * PQ, voff, (unsigned)__builtin_amdgcn_readfirstlane(vdst + (slot)))
    const int vb0 = (int)(lds0 + LDS_V) + ((lane >> 4) & 1) * 32 + (lane & 3) * 8 + (4 * hi + ((lane & 15) >> 2)) * 64;
    const char* Kbase = shm + LDS_K; bf16x8 kf[8];
    const lds_cptr shm3 = (lds_cptr)shm; const lds_cptr kp0 = shm3 + LDS_K + hi * 1024 + r32 * 16; const lds_cptr vp0 = shm3 + LDS_V + ((lane >> 4) & 1) * 32 + (lane & 3) * 8 + (4 * hi + ((lane & 15) >> 2)) * 64;
    const int NT = (q0 + QB) / KVBLK;
    DMA_K(0, 0); DMA_V(0, 0); DMA_K(1, SLOTB);
    bf16x8 qr[4];
#pragma unroll
    for (int d0 = 0; d0 < 4; ++d0) qr[d0] = *reinterpret_cast<const bf16x8*>(&Qw[(long)r32 * PQ + d0 * 16 + hi * 8]);
    float mhat = 0.f, l_reg = 0.f; f32x16 o[2]; o[0] = f32x16{}; o[1] = f32x16{}; const f32x16 negm = f32x16{};
    const int e0 = 2047 - (q0 + wid * QBLK + r32 - 4 * hi);
    const unsigned tab0 = lds0 + LDS_TAB + (unsigned)((e0 & 3) * ABT_COPY + 4 * (e0 & ~3));
#define CMASK(P0, P1, t) abias_tab(P0, P1, tab0 + 256u * (unsigned)(t), mhat)
    bool resc = false;
#define START(P0, P1) do { const float rm = rowmax(P0, P1); resc = false; \
    { const float dl = rm; mhat = fadd_s(mhat, dl); \
      _Pragma("unroll") for (int r = 0; r < 16; ++r) { P0[r] = fsub_s(P0[r], dl); P1[r] = fsub_s(P1[r], dl); } } \
    _Pragma("unroll") for (int r = 0; r < 16; ++r) P0[r] = __builtin_amdgcn_exp2f(P0[r]); } while (0)
#define RESC() do { if (resc) { asm volatile("s_waitcnt lgkmcnt(0)" ::: "memory"); \
      _Pragma("unroll") for (int d_ = 0; d_ < 2; ++d_) _Pragma("unroll") for (int r = 0; r < 16; ++r) o[d_][r] *= wsf[crow(r, hi)]; } } while (0)
    f32x16 pA0, pA1, pB0, pB1;
    int sl_prev = 0, sl_cur = 0, sl_next = SLOTB;
#define ROT() do { sl_prev = sl_cur; sl_cur = sl_next; sl_next = (sl_next == (NSLOT - 1) * SLOTB) ? 0 : sl_next + SLOTB; } while (0)
    DMA_K(2, 2 * SLOTB);
    WAIT_BAR(3);
    qkt(pA0, pA1, Kbase, qr, negm, r32, hi); asm volatile("s_nop 15\n\ts_nop 7" : "+v"(pA0), "+v"(pA1)); CMASK(pA0, pA1, 0);
    START(pA0, pA1);
    _Pragma("unroll") for (int r = 0; r < 16; ++r) pA1[r] = __builtin_amdgcn_exp2f(pA1[r]);
    WAIT_BAR(0);
    DMA_K(3, 0); DMA_V(1, SLOTB);
    ROT();
    kload8(kf, kp0 + sl_cur);
    WAIT_BAR(2);
    s16x4 vlo[8], vhi[8]; u32x4 pw0, pw1, pw2, pw3;
#define PKW(P, B) cvtpk_s(P[B], P[B + 1])
#define PAF(k) __builtin_bit_cast(bf16x8, pw##k)
#define VFR(i) (bf16x8){vlo[i][0], vlo[i][1], vlo[i][2], vlo[i][3], vhi[i][0], vhi[i][1], vhi[i][2], vhi[i][3]}
#define PIN(x) asm volatile("" : "+v"(x))
#define MX3(a, b, c) __builtin_fmaxf(__builtin_fmaxf((a), (b)), (c))
#define GAPA(MF, A0, A1, A2, A3, W0, W1, PW) do { MF; sacc += A0; sacc += A1; sacc += A2; sacc += A3; PIN(sacc); W0; W1; PIN(PW); SBAR(); } while (0)
#define EX(v) __builtin_amdgcn_exp2f(v)
#define GAPB(MF, X, B) do { MF; X[B] = EX(X[B]); X[B + 1] = EX(X[B + 1]); X[B + 2] = EX(X[B + 2]); X[B + 3] = EX(X[B + 3]); PIN(X); SBAR(); } while (0)
#define VRD(i) do { vlo[i] = vtr(vp_ + (((i) >> 2) * 4096 + ((i) & 3) * 1024)); vhi[i] = vtr(vp_ + (((i) >> 2) * 4096 + ((i) & 3) * 1024 + 512)); } while (0)
#define KRD(G, j) do { if (G) { kload2(kf, kp0 + sl_next, j); SBAR(); } } while (0)
#define STEP(C0, C1, P0, P1, t, GK, GV, GL, MASKFN) do { SBAR(); \
    const lds_cptr vp_ = vp0 + sl_prev; \
    VRD(0); SBAR(); float sacc = (P0[0] + P0[1]); \
    GAPA(C0 = __builtin_amdgcn_mfma_f32_32x32x16_bf16(kf[0], qr[0], negm, 0, 0, 0), P0[2], P0[3], P0[4], P0[5],     pw0[0] = PKW(P0, 0), pw0[1] = PKW(P0, 2), pw0); \
    VRD(4); SBAR(); GAPA(C1 = __builtin_amdgcn_mfma_f32_32x32x16_bf16(kf[1], qr[0], negm, 0, 0, 0), P0[6], P0[7], P0[8], P0[9],     pw0[2] = PKW(P0, 4), pw0[3] = PKW(P0, 6), pw0); \
    VRD(1); SBAR(); GAPA(C0 = __builtin_amdgcn_mfma_f32_32x32x16_bf16(kf[2], qr[1], C0, 0, 0, 0),   P0[10], P0[11], P0[12], P0[13], pw1[0] = PKW(P0, 8), pw1[1] = PKW(P0, 10), pw1); \
    VRD(5); SBAR(); GAPA(C1 = __builtin_amdgcn_mfma_f32_32x32x16_bf16(kf[3], qr[1], C1, 0, 0, 0),   P0[14], P0[15], P1[0], P1[1],   pw1[2] = PKW(P0, 12), pw1[3] = PKW(P0, 14), pw1); \
    VRD(2); SBAR(); GAPA(C0 = __builtin_amdgcn_mfma_f32_32x32x16_bf16(kf[4], qr[2], C0, 0, 0, 0),   P1[2], P1[3], P1[4], P1[5],     pw2[0] = PKW(P1, 0), pw2[1] = PKW(P1, 2), pw2); \
    VRD(6); SBAR(); GAPA(C1 = __builtin_amdgcn_mfma_f32_32x32x16_bf16(kf[5], qr[2], C1, 0, 0, 0),   P1[6], P1[7], P1[8], P1[9],     pw2[2] = PKW(P1, 4), pw2[3] = PKW(P1, 6), pw2); \
    VRD(3); SBAR(); GAPA(C0 = __builtin_amdgcn_mfma_f32_32x32x16_bf16(kf[6], qr[3], C0, 0, 0, 0),   P1[10], P1[11], P1[12], P1[13], pw3[0] = PKW(P1, 8), pw3[1] = PKW(P1, 10), pw3); \
    VRD(7); SBAR(); GAPA(C1 = __builtin_amdgcn_mfma_f32_32x32x16_bf16(kf[7], qr[3], C1, 0, 0, 0),   P1[14], P1[15], 0.f, 0.f,       pw3[2] = PKW(P1, 12), pw3[3] = PKW(P1, 14), pw3); \
    l_reg += sacc; \
    if (GK) { DMA_K((t) + 3, sl_cur); } if (GV) { DMA_V((t) + 1, sl_next); } \
    MASKFN(C0, C1, t); \
    { float a = MX3(C0[0], C0[1], C1[0]), b = MX3(C0[2], C0[3], C1[1]); a = MX3(a, C1[2], C1[3]); \
      _Pragma("unroll") for (int r = 4; r < 16; r += 4) { a = MX3(a, C0[r], C0[r + 1]); b = MX3(b, C0[r + 2], C0[r + 3]); a = MX3(a, C1[r], C1[r + 1]); b = MX3(b, C1[r + 2], C1[r + 3]); } \
      float rm = __builtin_fmaxf(a, b); { auto rr = __builtin_amdgcn_permlane32_swap(__float_as_uint(rm), __float_as_uint(rm), false, false); rm = __builtin_fmaxf(__uint_as_float(rr[0]), __uint_as_float(rr[1])); } \
      resc = false; \
      if (__builtin_expect(__any(rm > (float)THRL), 0)) { const float dl = __builtin_fmaxf(rm, 0.f); mhat += dl; \
        _Pragma("unroll") for (int r = 0; r < 16; ++r) { C0[r] -= dl; C1[r] -= dl; } \
        const float f = __builtin_amdgcn_exp2f(-dl); l_reg *= f; if (hi == 0) wsf[r32] = f; resc = true; } } \
    SBAR(); \
    GAPB(o[0] = __builtin_amdgcn_mfma_f32_32x32x16_bf16(PAF(0), VFR(0), o[0], 0, 0, 0), C0, 0); \
    GAPB(o[1] = __builtin_amdgcn_mfma_f32_32x32x16_bf16(PAF(0), VFR(4), o[1], 0, 0, 0), C0, 4); \
    KRD(GL, 0); GAPB(o[0] = __builtin_amdgcn_mfma_f32_32x32x16_bf16(PAF(1), VFR(1), o[0], 0, 0, 0), C0, 8); \
    KRD(GL, 1); GAPB(o[1] = __builtin_amdgcn_mfma_f32_32x32x16_bf16(PAF(1), VFR(5), o[1], 0, 0, 0), C0, 12); \
    KRD(GL, 2); GAPB(o[0] = __builtin_amdgcn_mfma_f32_32x32x16_bf16(PAF(2), VFR(2), o[0], 0, 0, 0), C1, 0); \
    KRD(GL, 3); GAPB(o[1] = __builtin_amdgcn_mfma_f32_32x32x16_bf16(PAF(2), VFR(6), o[1], 0, 0, 0), C1, 4); \
    GAPB(o[0] = __builtin_amdgcn_mfma_f32_32x32x16_bf16(PAF(3), VFR(3), o[0], 0, 0, 0), C1, 8); \
    GAPB(o[1] = __builtin_amdgcn_mfma_f32_32x32x16_bf16(PAF(3), VFR(7), o[1], 0, 0, 0), C1, 12); \
    } while (0)
    int t = 1;
    for (; t + 5 < NT; t += 2) {
        STEP(pB0, pB1, pA0, pA1, t, true, true, true, CMASK);     WAIT_BAR(2); RESC(); ROT();
        STEP(pA0, pA1, pB0, pB1, t + 1, true, true, true, CMASK); WAIT_BAR(2); RESC(); ROT();
    }
#define ENDW(tt) do { if ((tt) + 3 < NT) { WAIT_BAR(2); } else if ((tt) + 2 < NT) { WAIT_BAR(1); } else { WAIT_BAR(0); } } while (0)
    for (; t + 1 < NT; t += 2) {
        STEP(pB0, pB1, pA0, pA1, t, (t + 3 < NT), (t + 1 < NT), (t + 1 < NT), CMASK);         ENDW(t);     RESC(); ROT();
        STEP(pA0, pA1, pB0, pB1, t + 1, (t + 4 < NT), (t + 2 < NT), (t + 2 < NT), CMASK);     ENDW(t + 1); RESC(); ROT();
    }
    STEP(pB0, pB1, pA0, pA1, NT - 1, false, false, false, CMASK); RESC();
    { float sacc = pB0[0] + pB0[1]; _Pragma("unroll") for (int r = 2; r < 16; ++r) sacc += pB0[r]; _Pragma("unroll") for (int r = 0; r < 16; ++r) sacc += pB1[r]; l_reg += sacc;
      pw0 = (u32x4){PKW(pB0, 0), PKW(pB0, 2), PKW(pB0, 4), PKW(pB0, 6)}; pw1 = (u32x4){PKW(pB0, 8), PKW(pB0, 10), PKW(pB0, 12), PKW(pB0, 14)}; pw2 = (u32x4){PKW(pB1, 0), PKW(pB1, 2), PKW(pB1, 4), PKW(pB1, 6)}; pw3 = (u32x4){PKW(pB1, 8), PKW(pB1, 10), PKW(pB1, 12), PKW(pB1, 14)};
      SBAR(); pv(o, vb0 + sl_cur, PAF(0), PAF(1), PAF(2), PAF(3)); }
#undef PKW
#undef PAF
#undef VFR
#undef PIN
#undef MX3
#undef GAPA
#undef GAPB
#undef EX
#undef VRD
#undef KRD
#undef STEP
#undef ENDW
    { auto rr = __builtin_amdgcn_permlane32_swap(__float_as_uint(l_reg), __float_as_uint(l_reg), false, false); l_reg = __uint_as_float(rr[0]) + __uint_as_float(rr[1]); }
    if (hi == 0) wsf[32 + r32] = l_reg; asm volatile("s_waitcnt lgkmcnt(0)" ::: "memory");
    float rli[16];
#pragma unroll
    for (int r = 0; r < 16; ++r) rli[r] = __builtin_amdgcn_rcpf(wsf[32 + crow(r, hi)]);
    int lane_e = threadIdx.x & 63; asm volatile("" : "+v"(lane_e));
    const int r32e = lane_e & 31, hie = lane_e >> 5;
    bf16_t* Ow = Oh + (long)(q0 + wid * QBLK) * PO;
    { bf16_t* stg = (bf16_t*)(shm + LDS_OST) + wid * 2048;
#pragma unroll
      for (int r = 0; r < 16; ++r) { const int orow = crow(r, hie);
#pragma unroll
        for (int d0 = 0; d0 < 2; ++d0) stg[orow * 64 + d0 * 32 + r32e] = (bf16_t)f2bf(o[d0][r] * rli[r]); }
      asm volatile("s_waitcnt lgkmcnt(0)" ::: "memory");
#pragma unroll
      for (int i = 0; i < 4; ++i) { const int row = i * 8 + (lane_e >> 3), ch = lane_e & 7; const u32x4 v = *(const u32x4*)(stg + row * 64 + ch * 8);
        float xv[8]; xv[0] = bflo(v.x); xv[1] = bfhi(v.x); xv[2] = bflo(v.y); xv[3] = bfhi(v.y); xv[4] = bflo(v.z); xv[5] = bfhi(v.z); xv[6] = bflo(v.w); xv[7] = bfhi(v.w);
        float ss = 0.f;
#pragma unroll
        for (int j = 0; j < 8; ++j) ss += xv[j] * xv[j];
        ss = sum8(ss);
        const float rinv = 1.0f / sqrtf(ss * (1.0f / 64.0f) + LN_EPS);
        const f32x4 g0 = *(const f32x4*)(gn + ch * 8), g1 = *(const f32x4*)(gn + ch * 8 + 4);
        u32x4 w; w.x = pk2(xv[0] * rinv * g0[0], xv[1] * rinv * g0[1]); w.y = pk2(xv[2] * rinv * g0[2], xv[3] * rinv * g0[3]);
        w.z = pk2(xv[4] * rinv * g1[0], xv[5] * rinv * g1[1]); w.w = pk2(xv[6] * rinv * g1[2], xv[7] * rinv * g1[3]);
        *(u32x4*)(Ow + (long)row * PO + ch * 8) = w; } }
    asm volatile("s_waitcnt lgkmcnt(0)\n\ts_barrier" ::: "memory");
#undef DMA_K
#undef DMA_V
#undef CMASK
#undef START
#undef RESC
#undef ROT
}
#undef SBAR
#undef WAIT_BAR
}

__device__ __forceinline__ void p3_attention(Frame& F) {
    const float* in_a_norm_g = FIN(I_ANG);
    const bf16_t* PROJ = WSP(const bf16_t, WS_PROJ); bf16_t* CAT = WSP(bf16_t, WS_CAT);
    const int vcu = ((F.G & 7) == 0) ? (F.bx & 7) * (F.G >> 3) + (F.bx >> 3) : F.bx;
    for (int pr = vcu; pr < NB * AH * 4; pr += F.G) {
        const int bh = pr >> 2, s = pr & 3, b = bh / AH, h = bh % AH;
        const float slope2 = exp2f(-0.5f * (float)(h + 1)) * LOG2E;
        const bf16_t* base = PROJ + (size_t)b * SEQ * NPJ + h * ADH;
        bf16_t* ob = CAT + (size_t)b * SEQ * DM + DM / 2 + h * ADH;
        { LAS float* tab = (LAS float*)(F.lds + attn_body::LDS_TAB);
          for (int i = tid_id(); i < attn_body::ABT_N + 3; i += 512) { const float v = attn_body::bias1(2047 - i, slope2);
#pragma unroll
              for (int k = 0; k < 4; ++k) { const int j = i - k; if (j >= 0 && j < attn_body::ABT_N) tab[k * (attn_body::ABT_COPY / 4) + j] = v; } }
          __syncthreads(); }
#pragma unroll 1
        for (int j = 0; j < 2; ++j) {
            attn_body::attn_unit<8>(j ? 7 - s : s, base + PC_QA, base + PC_KA, base + PC_VA, ob, in_a_norm_g + h * ADH, slope2, (char*)F.lds);
            if (j == 0 && F.cgrp == 1) conv_gu(F, 16); }
    }
}

constexpr int ML_PK = 72;
constexpr int ML_PQ = 136;
__device__ __forceinline__ float log_sigmoid(float x) { return fminf(x, 0.f) - log1pf(__expf(-fabsf(x))); }
__device__ __forceinline__ float silu_f(float x) { return x * __builtin_amdgcn_rcpf(1.0f + __expf(-x)); }

__device__ __forceinline__ void mlstm_a_unit(Frame& F, int unit) {
    const int f_tid = tid_id();
    const int f_lane = lane_id();
    const float* in_conv_w = FIN(I_CONVW);
    const float* in_conv_b = FIN(I_CONVB);
    LAS unsigned char* lds = F.lds;
    LAS float* wsv = (LAS float*)lds;
    LAS bf16_t* KT = (LAS bf16_t*)(lds + 1024);
    LAS bf16_t* VT = (LAS bf16_t*)(lds + 1024 + 128 * ML_PK * 2);
    const int bh = unit >> 5, c = unit & 31, b = bh >> 2, h = bh & 3, row0 = b * SEQ + c * MCH;
    const bf16_t* PROJ = WSP(const bf16_t, WS_PROJ); const float* GATES = WSP(const float, WS_GATES);
    bf16_t* QC = WSP(bf16_t, WS_QC); bf16_t* KC = WSP(bf16_t, WS_KC);
    float* MSC = WSP(float, WS_MSC);
    float ig_ = 0.f, fg_ = 0.f;
    if (F.wave == 0) { const int row = row0 + f_lane; ig_ = GATES[(size_t)row * 8 + h]; fg_ = GATES[(size_t)row * 8 + 4 + h]; }
    {
        const int cp = f_tid & 127, rg = f_tid >> 7, col = 2 * cp, isk = col >> 7, cc = col & 127, pc = isk * 512 + h * 128 + cc;
        f32x2 cw[4];
#pragma unroll
        for (int j = 0; j < 4; ++j) cw[j] = *(const f32x2*)(in_conv_w + j * 1024 + pc);
        const f32x2 cbv = *(const f32x2*)(in_conv_b + pc);
        f32x2 xw[19];
#pragma unroll
        for (int i = 0; i < 19; ++i) { const int tp = c * MCH + rg * 16 + i - 3;
            unsigned w = 0u; if (tp >= 0) w = *(const unsigned*)(PROJ + (size_t)(b * SEQ + tp) * NPJ + pc);
            xw[i] = (f32x2){bflo(w), bfhi(w)}; }
#pragma unroll
        for (int i = 0; i < 16; ++i) { const int s = rg * 16 + i;
            f32x2 y = cbv + cw[0] * xw[i] + cw[1] * xw[i + 1] + cw[2] * xw[i + 2] + cw[3] * xw[i + 3];
            y[0] = silu_f(y[0]); y[1] = silu_f(y[1]);
            if (isk) { y = y * 0.08838834764831845f; const unsigned pw = pk2(y[0], y[1]);
                *(unsigned*)(KC + (size_t)(row0 + s) * 512 + h * 128 + cc) = pw;
                KT[cc * ML_PK + s] = (bf16_t)(pw & 0xffffu); KT[(cc + 1) * ML_PK + s] = (bf16_t)(pw >> 16); }
            else *(unsigned*)(QC + (size_t)(row0 + s) * 512 + h * 128 + cc) = pk2(y[0], y[1]); }
        if (F.wave == 0) {
            float bcum = log_sigmoid(fg_);
            bcum = wave_scan_sum(bcum);
            const float bl = __builtin_bit_cast(float, __builtin_amdgcn_readlane(__builtin_bit_cast(int, bcum), 63));
            const float g = bl - bcum + ig_; const float mloc = wave_max(g);
            wsv[f_lane] = __expf(g - mloc);
            if (f_lane == 0) { MSC[unit] = bl; MSC[512 + unit] = mloc; }
        }
        __syncthreads();
        const int vp = f_tid & 127;
#pragma unroll 4
        for (int i = 0; i < 16; ++i) { const int s = rg * 16 + i; const float w = wsv[s];
            const unsigned x = *(const unsigned*)(PROJ + (size_t)(row0 + s) * NPJ + PC_VM + h * MDV + 2 * vp);
            VT[(2 * vp) * ML_PK + s] = (bf16_t)f2bf(bflo(x) * w); VT[(2 * vp + 1) * ML_PK + s] = (bf16_t)f2bf(bfhi(x) * w); }
    }
    __syncthreads();
    {
        const int r32 = f_lane & 31, hi = f_lane >> 5, w = F.wave;
        f32x16 acc[4];
#pragma unroll
        for (int db = 0; db < 4; ++db) acc[db] = f32x16{};
#pragma unroll
        for (int ks = 0; ks < 4; ++ks) { const bf16x8 a = *(const LAS bf16x8*)(VT + (32 * w + r32) * ML_PK + 16 * ks + 8 * hi);
#pragma unroll
            for (int db = 0; db < 4; ++db) { const bf16x8 bq = *(const LAS bf16x8*)(KT + (32 * db + r32) * ML_PK + 16 * ks + 8 * hi);
                acc[db] = __builtin_amdgcn_mfma_f32_32x32x16_bf16(a, bq, acc[db], 0, 0, 0); } }
        float* U = WSP(float, WS_U) + (size_t)unit * (MDV * MDQK);
#pragma unroll
        for (int db = 0; db < 4; ++db)
#pragma unroll
            for (int i = 0; i < 16; ++i) { const int v = 32 * w + (i & 3) + 8 * (i >> 2) + 4 * hi; U[v * MDQK + 32 * db + r32] = acc[db][i]; }
        if (f_tid < MDQK) { float s = 0.f;
#pragma unroll 8
            for (int q = 0; q < MCH; ++q) s += wsv[q] * bf2f(KT[f_tid * ML_PK + q]);
            MSC[2048 + unit * MDQK + f_tid] = s; }
    }
    __syncthreads();
}
__device__ __forceinline__ void mlstm_b_scan(Frame& F) {
    const int f_tid = tid_id();
    const float* U = WSP(const float, WS_U); bf16_t* CST = WSP(bf16_t, WS_CST); float* MSC = WSP(float, WS_MSC);
    const int gt = F.bx * 512 + f_tid, NTH = F.G * 512;
    for (int idx = gt; idx < 16 * 8192; idx += NTH) {
        const int bh = idx >> 13, off = (idx & 8191) * 4;
        float m = 0.f; f32x4 C = {0.f, 0.f, 0.f, 0.f};
#pragma unroll 4
        for (int c = 0; c < NCH; ++c) { const int un = bh * NCH + c; const size_t base = (size_t)un * (MDV * MDQK) + off;
            u32x2 o; o.x = pk2(C[0], C[1]); o.y = pk2(C[2], C[3]); *(u32x2*)(CST + base) = o;
            if ((idx & 8191) == 0) MSC[1024 + un] = m;
            const float Bc = MSC[un], ml = MSC[512 + un];
            const float mn = fmaxf(Bc + m, ml), dec = __expf(Bc + m - mn), inj = __expf(ml - mn);
            const f32x4 u = __builtin_nontemporal_load((const f32x4*)(U + base));
            C = C * dec + u * inj; m = mn; }
    }
    if (gt < 16 * 32) {
        const int bh = gt >> 5, off = (gt & 31) * 4;
        float m = 0.f; f32x4 n = {0.f, 0.f, 0.f, 0.f};
        for (int c = 0; c < NCH; ++c) { const int un = bh * NCH + c;
            *(f32x4*)(MSC + 2048 + 65536 + un * MDQK + off) = n;
            const float Bc = MSC[un], ml = MSC[512 + un];
            const float mn = fmaxf(Bc + m, ml), dec = __expf(Bc + m - mn), inj = __expf(ml - mn);
            const f32x4 u = *(const f32x4*)(MSC + 2048 + un * MDQK + off);
            n = n * dec + u * inj; m = mn; }
    }
}
__device__ __forceinline__ void mlstm_c_unit(Frame& F, int unit) {
    const int f_tid = tid_id();
    const int f_lane = lane_id();
    const float* in_m_norm_g = FIN(I_MNG);
    LAS unsigned char* lds = F.lds;
    LAS float* su = (LAS float*)lds;
    LAS float* sM = su + 64; LAS float* sbt = su + 128; LAS float* sei = su + 192; LAS float* snq = su + 256; LAS float* sden = su + 320;
    LAS bf16_t* Qs = (LAS bf16_t*)(lds + 2048);
    LAS bf16_t* Ks = (LAS bf16_t*)(lds + 2048 + 64 * ML_PQ * 2);
    LAS bf16_t* VT = (LAS bf16_t*)(lds + 2048 + 2 * 64 * ML_PQ * 2);
    LAS float* Hs = (LAS float*)(lds + 2048);
    const int bh = unit >> 5, c = unit & 31, b = bh >> 2, h = bh & 3, row0 = b * SEQ + c * MCH;
    const bf16_t* PROJ = WSP(const bf16_t, WS_PROJ); const float* GATES = WSP(const float, WS_GATES);
    const bf16_t* QC = WSP(const bf16_t, WS_QC); const bf16_t* KC = WSP(const bf16_t, WS_KC);
    const float* MSC = WSP(const float, WS_MSC); const bf16_t* CST = WSP(const bf16_t, WS_CST) + (size_t)unit * (MDV * MDQK);
    bf16_t* CAT = WSP(bf16_t, WS_CAT);
    bf16x8 cfr[8];
    { const int r32c = f_lane & 31, hic = f_lane >> 5;
#pragma unroll
      for (int st = 0; st < 8; ++st) cfr[st] = *(const bf16x8*)(CST + (size_t)(32 * F.wave + r32c) * MDQK + 16 * st + 8 * hic); }
    f32x4 nq0, nq1, nq2, nq3;
    { const float* nst = MSC + 2048 + 65536 + unit * MDQK + 16 * (f_tid & 7); nq0 = *(const f32x4*)nst; nq1 = *(const f32x4*)(nst + 4); nq2 = *(const f32x4*)(nst + 8); nq3 = *(const f32x4*)(nst + 12); }
    float ig_ = 0.f, fg_ = 0.f, mc_ = 0.f;
    if (F.wave == 0) { const int row = row0 + f_lane; ig_ = GATES[(size_t)row * 8 + h]; fg_ = GATES[(size_t)row * 8 + 4 + h]; mc_ = MSC[1024 + unit]; }
#pragma unroll
    for (int i = 0; i < 4; ++i) { const int idx = f_tid + 512 * i, mat = idx >> 10, row = (idx >> 4) & 63, ch = idx & 15;
        const u32x4 v = *(const u32x4*)((mat ? KC : QC) + (size_t)(row0 + row) * 512 + h * 128 + ch * 8);
        *(LAS u32x4*)((mat ? Ks : Qs) + row * ML_PQ + ch * 8) = v; }
    { const int vp = f_tid & 127, rg = f_tid >> 7;
#pragma unroll 4
        for (int i = 0; i < 16; ++i) { const int s = rg * 16 + i;
            const unsigned x = *(const unsigned*)(PROJ + (size_t)(row0 + s) * NPJ + PC_VM + h * MDV + 2 * vp);
            VT[(2 * vp) * ML_PK + s] = (bf16_t)(x & 0xffffu); VT[(2 * vp + 1) * ML_PK + s] = (bf16_t)(x >> 16); } }
    if (F.wave == 0) {
        float bcum = log_sigmoid(fg_);
        bcum = wave_scan_sum(bcum);
        const float u = ig_ - bcum; const float pm = wave_scan_max(u);
        const float M = fmaxf(mc_, pm);
        su[f_lane] = u; sM[f_lane] = M; sbt[f_lane] = bcum; sei[f_lane] = __expf(mc_ - M);
    }
    __syncthreads();
    {
        const int t = f_tid >> 3, p = f_tid & 7; float s = 0.f;
        const u32x4 qa = *(const LAS u32x4*)(Qs + t * ML_PQ + 16 * p), qb = *(const LAS u32x4*)(Qs + t * ML_PQ + 16 * p + 8);
        const f32x4 n0 = nq0, n1 = nq1, n2 = nq2, n3 = nq3;
        s += bflo(qa.x) * n0[0] + bfhi(qa.x) * n0[1] + bflo(qa.y) * n0[2] + bfhi(qa.y) * n0[3] + bflo(qa.z) * n1[0] + bfhi(qa.z) * n1[1] + bflo(qa.w) * n1[2] + bfhi(qa.w) * n1[3];
        s += bflo(qb.x) * n2[0] + bfhi(qb.x) * n2[1] + bflo(qb.y) * n2[2] + bfhi(qb.y) * n2[3] + bflo(qb.z) * n3[0] + bfhi(qb.z) * n3[1] + bflo(qb.w) * n3[2] + bfhi(qb.w) * n3[3];
        s = sum8(s);
        if (p == 0) snq[t] = s; }
    int lane_o = f_lane; asm volatile("" : "+v"(lane_o));
    const int r32 = lane_o & 31, hi = lane_o >> 5, w = F.wave;
    f32x16 accI[2], accC[2];
    LAS u32x4* AF = (LAS u32x4*)(lds + 2048 + 2 * 64 * ML_PQ * 2 + 256 * ML_PK * 2);
    LAS float* sdp = su + 384;
    if (w < 3) {
        const int fi = w, tb = fi ? 1 : 0, sb = fi == 2 ? 1 : 0, t = 32 * tb + r32; const float Mt = sM[t];
        f32x16 X = {};
#pragma unroll
        for (int st = 0; st < 8; ++st) { const bf16x8 a = *(const LAS bf16x8*)(Ks + (32 * sb + r32) * ML_PQ + 16 * st + 8 * hi), bq = *(const LAS bf16x8*)(Qs + t * ML_PQ + 16 * st + 8 * hi);
            X = __builtin_amdgcn_mfma_f32_32x32x16_bf16(a, bq, X, 0, 0, 0); }
        float av[16]; float den = 0.f;
#pragma unroll
        for (int i = 0; i < 16; ++i) { const int s = 32 * sb + (i & 3) + 8 * (i >> 2) + 4 * hi;
            const float e = (s <= t) ? __expf(su[s] - Mt) * X[i] : 0.f; av[i] = e; den += e; }
#pragma unroll
        for (int ss = 0; ss < 2; ++ss) { u32x4 p; p.x = pk2(av[8 * ss], av[8 * ss + 1]); p.y = pk2(av[8 * ss + 2], av[8 * ss + 3]); p.z = pk2(av[8 * ss + 4], av[8 * ss + 5]); p.w = pk2(av[8 * ss + 6], av[8 * ss + 7]);
            AF[(fi * 2 + ss) * 64 + lane_o] = p; }
        den += __shfl_xor(den, 32);
        if (hi == 0) sdp[fi * 32 + r32] = den;
    }
    u32x4 ogv[4];
    { const bf16_t* op = PROJ + (size_t)(row0 + (f_tid >> 3)) * NPJ + PC_OM + h * MDV + 32 * (f_tid & 7);
#pragma unroll
      for (int q = 0; q < 4; ++q) ogv[q] = *(const u32x4*)(op + 8 * q); }
    accC[0] = f32x16{}; accC[1] = f32x16{};
#pragma unroll
    for (int st = 0; st < 8; ++st) { const bf16x8 bq = cfr[st];
#pragma unroll
        for (int tb = 0; tb < 2; ++tb) { const bf16x8 a = *(const LAS bf16x8*)(Qs + (32 * tb + r32) * ML_PQ + 16 * st + 8 * hi);
            accC[tb] = __builtin_amdgcn_mfma_f32_32x32x16_bf16(a, bq, accC[tb], 0, 0, 0); } }
    __syncthreads();
#pragma unroll
    for (int tb = 0; tb < 2; ++tb) { accI[tb] = f32x16{};
#pragma unroll
        for (int sb = 0; sb <= tb; ++sb)
#pragma unroll
            for (int ss = 0; ss < 2; ++ss) { const LAS bf16_t* vp = VT + (32 * w + r32) * ML_PK + 32 * sb + 16 * ss + 4 * hi;
                const s16x4 lo = *(const LAS s16x4*)vp, hh = *(const LAS s16x4*)(vp + 8);
                const bf16x8 bq = (bf16x8){lo[0], lo[1], lo[2], lo[3], hh[0], hh[1], hh[2], hh[3]};
                const bf16x8 af = __builtin_bit_cast(bf16x8, AF[((tb + sb) * 2 + ss) * 64 + lane_o]);
                accI[tb] = __builtin_amdgcn_mfma_f32_32x32x16_bf16(af, bq, accI[tb], 0, 0, 0); } }
    if (f_tid < MCH) sden[f_tid] = f_tid < 32 ? sdp[f_tid] : sdp[32 + (f_tid - 32)] + sdp[64 + (f_tid - 32)];
    __syncthreads();
    if (f_tid < MCH) {
        const float ei = sei[f_tid], dn = sden[f_tid] + ei * snq[f_tid];
        sden[f_tid] = __builtin_amdgcn_rcpf(fmaxf(fabsf(dn), __expf(-sbt[f_tid] - sM[f_tid]))); }
    __syncthreads();
#pragma unroll
    for (int tb = 0; tb < 2; ++tb)
#pragma unroll
        for (int i = 0; i < 16; ++i) { const int t = 32 * tb + (i & 3) + 8 * (i >> 2) + 4 * hi;
            Hs[t * 257 + 32 * w + r32] = (accI[tb][i] + sei[t] * accC[tb][i]) * sden[t]; }
    __syncthreads();
    {
        const int t = f_tid >> 3, p = f_tid & 7;
        float x[32]; float ss = 0.f;
#pragma unroll
        for (int j = 0; j < 32; ++j) { x[j] = Hs[t * 257 + 32 * p + j]; ss += x[j] * x[j]; }
        ss = sum8(ss);
        const float rinv = 1.0f / sqrtf(ss * (1.0f / MDV) + LN_EPS);
        const float* gp = in_m_norm_g + h * MDV + 32 * p;
        bf16_t* dst = CAT + (size_t)(row0 + t) * DM + h * MDV + 32 * p;
#pragma unroll
        for (int q = 0; q < 4; ++q) { const u32x4 ov = ogv[q];
            float og[8]; og[0] = bflo(ov.x); og[1] = bfhi(ov.x); og[2] = bflo(ov.y); og[3] = bfhi(ov.y); og[4] = bflo(ov.z); og[5] = bfhi(ov.z); og[6] = bflo(ov.w); og[7] = bfhi(ov.w);
            const f32x4 ga = *(const f32x4*)(gp + 8 * q), gb = *(const f32x4*)(gp + 8 * q + 4);
            const float gq[8] = {ga[0], ga[1], ga[2], ga[3], gb[0], gb[1], gb[2], gb[3]};
            float r[8];
#pragma unroll
            for (int j = 0; j < 8; ++j) r[j] = x[8 * q + j] * rinv * gq[j] * __builtin_amdgcn_rcpf(1.0f + __expf(-og[j]));
            u32x4 wv; wv.x = pk2(r[0], r[1]); wv.y = pk2(r[2], r[3]); wv.z = pk2(r[4], r[5]); wv.w = pk2(r[6], r[7]);
            *(u32x4*)(dst + 8 * q) = wv; }
    }
    __syncthreads();
}

constexpr int NPHASE = 11;
struct Args { const float* in[21]; float* out; unsigned char* ws; int lo, hi; };
__global__ void __launch_bounds__(512, 2) mega_fwd(Args args) {
    extern __shared__ __attribute__((aligned(16))) unsigned char lds_raw[];
    Frame F;
    F.lds = (LAS unsigned char*)lds_raw;
    F.wave = __builtin_amdgcn_readfirstlane((int)threadIdx.x >> 6);
    F.G = gridDim.x; F.bx = blockIdx.x; F.cgu = 0; F.cdn = 0; F.cgrp = (F.bx >> 3) & 3;
    F.ws = args.ws;
    F.in = args.in; F.outp = &args.out;
    volatile LAS unsigned* MISC = (volatile LAS unsigned*)(F.lds + MISC_OFF);
    if (threadIdx.x < 64) MISC[threadIdx.x] = 0u;
    __syncthreads();
    const int lo = args.lo, hi = args.hi;
    XcdBarrier bar; bar.bar = ((unsigned*)F.ws) + CW_BAR; bar.x = 0; bar.st = nullptr;
    if (hi - lo > 1) bar = xcd_barrier_post(((unsigned*)F.ws) + CW_BAR, MISC + 8);
#ifndef PH_MASK
#define PH_MASK 0x7ff
#endif
#define IN(k) (((PH_MASK >> (k)) & 1) && lo <= (k) && (k) < hi)
#define SEAM(k) do { if (IN(k) && IN((k) + 1)) xcd_barrier(bar); } while (0)

#ifndef CVQ_GU
#define CVQ_GU 16
#endif
#ifndef DBG_DOUBLE
#define DBG_DOUBLE 0
#endif
#define PHASE(k, ...) do { if (IN(k)) { __VA_ARGS__ if constexpr ((DBG_DOUBLE >> (k)) & 1) { xcd_barrier(bar); __VA_ARGS__ } } SEAM(k); } while (0)
    PHASE(0, { p0_prologue(F); });
    PHASE(1, { p1_modulate(F); });
    PHASE(2, {
        if (F.cgrp == 0) conv_gu(F, CVQ_GU);
        PbProj P; P.Fp = &F; P.hook_unit = F.cgrp - 1; P.hook_n = (F.cgrp == 1 || F.cgrp == 2) ? CVQ_GU : 0; P.Abase = (const char*)WSP(bf16_t, WS_H); P.Bt = (const char*)WSP(bf16_t, WS_WIN_T); P.S.init(NTOK, NPJ, F.G, F.bx); P.O = WSP(bf16_t, WS_PROJ); P.bias = WSP(const float, WS_BIN2);
        pg8::gemm_phase<PbProj>(F.lds, P);
        if (F.cgrp == 3) conv_gu(F, CVQ_GU); });
    PHASE(3, {
        if (F.cgrp == 0) conv_gu(F, 16);
        p3_attention(F);
        if (F.cgrp == 2) conv_gu(F, 16);
        for (int u = F.bx; u < 16 * NCH; u += F.G) mlstm_a_unit(F, u);
        if (F.cgrp == 3) conv_gu(F, 16); });
    PHASE(4, { mlstm_b_scan(F); });
    PHASE(5, { for (int u = F.bx; u < 16 * NCH; u += F.G) mlstm_c_unit(F, u); });
    PHASE(6, {
        PbOut P; P.Abase = (const char*)WSP(bf16_t, WS_CAT); P.Bt = (const char*)WSP(bf16_t, WS_WOUT_T); P.S.init(NTOK, DM, F.G, F.bx); P.C = WSP(bf16_t, WS_Y1);
        pg8::gemm_phase<PbOut>(F.lds, P); });
    PHASE(7, { p7_ln1_router(F); conv_gu(F, 64); });
    PHASE(8, {
        if (F.cgrp == 0) conv_dn(F, 64);
        PbGu P; P.Fp = &F; P.hook_unit = 2 * F.cgrp - 1; P.hook_n = F.cgrp ? 64 : 0; P.T.lds = F.lds; P.T.nun = moe_setup(F, 16);
        P.Abase = (const char*)WSP(unsigned char, WS_H2Q); P.Wt = (const char*)WSP(unsigned char, WS_WGU_T); P.bias = WSP(const float, WS_BGU2); P.ACT = WSP(unsigned char, WS_ACT);
        pg8::gemm_phase<PbGu>(F.lds, P);
        conv_dn(F, 64); });
    PHASE(9, {
        PbDn P; P.T.lds = F.lds; P.T.nun = moe_setup(F, 8);
        P.Abase = (const char*)WSP(unsigned char, WS_ACT); P.Wt = (const char*)WSP(unsigned char, WS_WDN_T); P.bias = FIN(I_BDN); P.YP = WSP(unsigned char, WS_YP);
        pg8::gemm_phase<PbDn>(F.lds, P); });
    PHASE(10, { p10_ln2(F); });
#undef PHASE
#undef IN
#undef SEAM
}

extern "C" void kernel_launch(void* const* d_in, const int* in_sizes, int n_in, void* d_out, int out_size, void* d_ws, size_t ws_size, hipStream_t stream) {
    static int grid = 0;
    if (!grid) {
        int dev = 0, cus = 0, per_cu = 0;
        if (n_in != 21 || ws_size < WS_END) { fprintf(stderr, "kernel_launch: unexpected n_in %d or ws_size %zu\n", n_in, ws_size); return; }
        (void)hipGetDevice(&dev);
        (void)hipDeviceGetAttribute(&cus, hipDeviceAttributeMultiprocessorCount, dev);
        if (hipFuncSetAttribute((const void*)mega_fwd, hipFuncAttributeMaxDynamicSharedMemorySize, LDS_BYTES) != hipSuccess) { fprintf(stderr, "kernel_launch: hipFuncSetAttribute failed\n"); return; }
        if (hipOccupancyMaxActiveBlocksPerMultiprocessor(&per_cu, (const void*)mega_fwd, 512, LDS_BYTES) != hipSuccess || per_cu < 1) { fprintf(stderr, "kernel_launch: occupancy query says %d\n", per_cu); per_cu = 1; }
        grid = cus;
    }
    (void)hipMemsetAsync((char*)d_ws + WS_CTL, 0, CTL_ZERO_BYTES, stream);
    Args a{};
    for (int i = 0; i < 21; ++i) a.in[i] = (const float*)d_in[i];
    a.out = (float*)d_out; a.ws = (unsigned char*)d_ws;
#if N_LAUNCH_MODE == 1
    a.lo = 0; a.hi = NPHASE;
    hipLaunchKernelGGL(mega_fwd, dim3(grid), dim3(512), LDS_BYTES, stream, a);
#else
    for (int k = 0; k < NPHASE; ++k) { a.lo = k; a.hi = k + 1; hipLaunchKernelGGL(mega_fwd, dim3(grid), dim3(512), LDS_BYTES, stream, a); }
#endif
    hipError_t le = hipGetLastError();
    if (le != hipSuccess) fprintf(stderr, "kernel_launch: launch failed: %s\n", hipGetErrorName(le));
}
```
